# Optimizing an MI355X kernel written in HIP

```python
import jax, jax.numpy as jnp
from jax import lax
import numpy as np

D_MODEL = 1024
BATCH = 8
SEQ = 8192
DEPTH = 2

HEAD_DIM = 64
N_HEADS_A = D_MODEL // (2 * HEAD_DIM)
N_HEADS_B = D_MODEL // (2 * HEAD_DIM)
N_KV_B = N_HEADS_B // 4
N_HEADS_C = D_MODEL // HEAD_DIM
WINDOW_B = 128
DILATION_PAIRS = ((128, 1), (512, 4), (2048, 16))
BLOCK = 128
D_FF = 4 * D_MODEL
EPS = 1e-6
EVEN_IN_WIDTH = 3 * N_HEADS_A * HEAD_DIM + N_HEADS_B * HEAD_DIM + 2 * N_KV_B * HEAD_DIM
EVEN_MIX_WIDTH = (N_HEADS_A + N_HEADS_B) * HEAD_DIM
ODD_IN_WIDTH = 3 * N_HEADS_C * HEAD_DIM + N_HEADS_C
ODD_MIX_WIDTH = N_HEADS_C * HEAD_DIM

kernel_name = "hybrid_dilated_swa_sink_fox_sqrelu"


def rms_norm(x, gain):
    xf = x.astype(jnp.float32)
    y = xf * lax.rsqrt(jnp.mean(xf * xf, axis=-1, keepdims=True) + EPS)
    return (y * gain.astype(jnp.float32)).astype(x.dtype)


def alibi_slopes(n):
    return jnp.asarray(2.0 ** (-8.0 * np.arange(1, n + 1) / n), dtype=jnp.float32)


def dilated_attention(q, k, v, slopes):
    bsz, seq, nh, dh = q.shape
    nblk = seq // BLOCK
    scale = dh ** -0.5
    q_blocks = jnp.moveaxis(q.reshape(bsz, nblk, BLOCK, nh, dh), 1, 0)
    slope_b = slopes[None, :, None, None]

    def block_fn(args):
        blk, qb = args
        t = blk * BLOCK + jnp.arange(BLOCK)
        parts = []
        for window, dil in DILATION_PAIRS:
            dist = jnp.arange(window // dil + 1) * dil
            idx = t[:, None] - dist[None, :]
            valid = idx >= 0
            idx = jnp.maximum(idx, 0)
            kg = k[:, idx]
            vg = v[:, idx]
            s = jnp.einsum("bqhd,bqjhd->bhqj", qb, kg).astype(jnp.float32) * scale
            s = s - slope_b * dist.astype(jnp.float32)
            s = jnp.where(valid[None, None], s, -jnp.inf)
            m = jnp.max(s, axis=-1, keepdims=True)
            p = jnp.exp(s - m)
            den = jnp.sum(p, axis=-1, keepdims=True)
            num = jnp.einsum("bhqj,bqjhd->bhqd", p.astype(v.dtype), vg).astype(jnp.float32)
            parts.append((m, num, den))
        m_all = parts[0][0]
        for m, _, _ in parts[1:]:
            m_all = jnp.maximum(m_all, m)
        num_all = 0.0
        den_all = 0.0
        for m, num, den in parts:
            w = jnp.exp(m - m_all)
            num_all = num_all + w * num
            den_all = den_all + w * den
        out = num_all / den_all
        return jnp.transpose(out, (0, 2, 1, 3)).astype(q.dtype)

    out = lax.map(block_fn, (jnp.arange(nblk), q_blocks))
    return jnp.moveaxis(out, 0, 1).reshape(bsz, seq, nh, dh)


def sliding_window_sink_attention(q, k, v, sinks, slopes):
    bsz, seq, nhq, dh = q.shape
    nkv = k.shape[2]
    grp = nhq // nkv
    nblk = seq // BLOCK
    scale = dh ** -0.5
    qb = q.reshape(bsz, nblk, BLOCK, nkv, grp, dh)
    pad = ((0, 0), (BLOCK, 0), (0, 0), (0, 0))
    kp = jnp.pad(k, pad).reshape(bsz, nblk + 1, BLOCK, nkv, dh)
    vp = jnp.pad(v, pad).reshape(bsz, nblk + 1, BLOCK, nkv, dh)
    kw = jnp.concatenate([kp[:, :-1], kp[:, 1:]], axis=2)
    vw = jnp.concatenate([vp[:, :-1], vp[:, 1:]], axis=2)
    s = jnp.einsum("bnqkgd,bnskd->bnkgqs", qb, kw).astype(jnp.float32) * scale
    qpos = jnp.arange(BLOCK)
    kpos = jnp.arange(2 * BLOCK)
    dist = qpos[:, None] - kpos[None, :] + BLOCK
    abs_k = jnp.arange(nblk)[:, None] * BLOCK + kpos[None, :] - BLOCK
    valid = ((dist >= 0) & (dist < WINDOW_B))[None] & (abs_k >= 0)[:, None, :]
    slope_kg = slopes.reshape(nkv, grp)[:, :, None, None]
    s = s - slope_kg * dist.astype(jnp.float32)
    s = jnp.where(valid[None, :, None, None], s, -jnp.inf)
    sink = sinks.astype(jnp.float32).reshape(nkv, grp)[:, :, None, None]
    m = jnp.maximum(jnp.max(s, axis=-1, keepdims=True), sink)
    p = jnp.exp(s - m)
    den = jnp.sum(p, axis=-1) + jnp.exp(sink - m)[..., 0]
    num = jnp.einsum("bnkgqs,bnskd->bnqkgd", p.astype(v.dtype), vw).astype(jnp.float32)
    out = num / jnp.transpose(den, (0, 1, 4, 2, 3))[..., None]
    return out.astype(q.dtype).reshape(bsz, seq, nhq, dh)


def forgetting_attention(q, k, v, log_f):
    bsz, seq, nh, dh = q.shape
    nblk = seq // BLOCK
    scale = dh ** -0.5
    c = jnp.cumsum(log_f, axis=1)
    c_k = jnp.transpose(c, (0, 2, 1))
    q_blocks = jnp.moveaxis(q.reshape(bsz, nblk, BLOCK, nh, dh), 1, 0)
    c_blocks = jnp.moveaxis(c.reshape(bsz, nblk, BLOCK, nh), 1, 0)
    key_pos = jnp.arange(seq)

    def block_fn(args):
        blk, qb, cq = args
        t = blk * BLOCK + jnp.arange(BLOCK)
        s = jnp.einsum("bqhd,bshd->bhqs", qb, k).astype(jnp.float32) * scale
        s = s + jnp.transpose(cq, (0, 2, 1))[..., None] - c_k[:, :, None, :]
        s = jnp.where((key_pos[None, :] <= t[:, None])[None, None], s, -jnp.inf)
        p = jax.nn.softmax(s, axis=-1)
        return jnp.einsum("bhqs,bshd->bqhd", p.astype(v.dtype), v)

    out = lax.map(block_fn, (jnp.arange(nblk), q_blocks, c_blocks))
    return jnp.moveaxis(out, 0, 1).reshape(bsz, seq, nh, dh)


def even_mixer(h, w_in, a_q_gain, a_k_gain, b_q_gain, b_k_gain, b_sinks, w_out):
    bsz, seq, _ = h.shape
    proj = jnp.einsum("bsd,de->bse", h, w_in)
    widths = [N_HEADS_A * HEAD_DIM] * 3 + [N_HEADS_B * HEAD_DIM, N_KV_B * HEAD_DIM, N_KV_B * HEAD_DIM]
    offs = np.cumsum(widths)[:-1].tolist()
    aq, ak, av, bq, bk, bv = jnp.split(proj, offs, axis=-1)
    aq = rms_norm(aq.reshape(bsz, seq, N_HEADS_A, HEAD_DIM), a_q_gain)
    ak = rms_norm(ak.reshape(bsz, seq, N_HEADS_A, HEAD_DIM), a_k_gain)
    av = av.reshape(bsz, seq, N_HEADS_A, HEAD_DIM)
    bq = rms_norm(bq.reshape(bsz, seq, N_HEADS_B, HEAD_DIM), b_q_gain)
    bk = rms_norm(bk.reshape(bsz, seq, N_KV_B, HEAD_DIM), b_k_gain)
    bv = bv.reshape(bsz, seq, N_KV_B, HEAD_DIM)
    slopes = alibi_slopes(N_HEADS_B + N_HEADS_A)
    a_out = dilated_attention(aq, ak, av, slopes[N_HEADS_B:])
    b_out = sliding_window_sink_attention(bq, bk, bv, b_sinks, slopes[:N_HEADS_B])
    y = jnp.concatenate([a_out.reshape(bsz, seq, -1), b_out.reshape(bsz, seq, -1)], axis=-1)
    return jnp.einsum("bse,ed->bsd", y, w_out)


def odd_mixer(h, w_in, b_forget, c_q_gain, c_k_gain, w_out):
    bsz, seq, _ = h.shape
    proj = jnp.einsum("bsd,de->bse", h, w_in)
    w = N_HEADS_C * HEAD_DIM
    q = rms_norm(proj[..., :w].reshape(bsz, seq, N_HEADS_C, HEAD_DIM), c_q_gain)
    k = rms_norm(proj[..., w:2 * w].reshape(bsz, seq, N_HEADS_C, HEAD_DIM), c_k_gain)
    v = proj[..., 2 * w:3 * w].reshape(bsz, seq, N_HEADS_C, HEAD_DIM)
    f_logit = proj[..., 3 * w:].astype(jnp.float32) + b_forget.astype(jnp.float32)
    log_f = jax.nn.log_sigmoid(f_logit)
    y = forgetting_attention(q, k, v, log_f)
    return jnp.einsum("bse,ed->bsd", y.reshape(bsz, seq, w), w_out)


def squared_relu_mlp(h, w_up, w_down):
    u = jnp.einsum("bsd,df->bsf", h, w_up)
    return jnp.einsum("bsf,fd->bsd", jnp.square(jax.nn.relu(u)), w_down)


def setup_inputs(seed: int = 0) -> dict:
    key = jax.random.key(seed)
    ks = jax.random.split(key, 18)
    n_even = (DEPTH + 1) // 2
    n_odd = DEPTH // 2
    d = D_MODEL

    def nrm(k, shape, fan_in):
        return jax.random.normal(k, shape, jnp.float32) * fan_in ** -0.5

    def gain(k, shape):
        return 1.0 + 0.02 * jax.random.normal(k, shape, jnp.float32)

    return {
        "x": jax.random.normal(ks[0], (BATCH, SEQ, d), jnp.float32),
        "g_mix": gain(ks[1], (DEPTH, d)),
        "g_mlp": gain(ks[2], (DEPTH, d)),
        "w_in_even": nrm(ks[3], (n_even, d, EVEN_IN_WIDTH), d),
        "a_q_gain": gain(ks[4], (n_even, HEAD_DIM)),
        "a_k_gain": gain(ks[5], (n_even, HEAD_DIM)),
        "b_q_gain": gain(ks[6], (n_even, HEAD_DIM)),
        "b_k_gain": gain(ks[7], (n_even, HEAD_DIM)),
        "b_sinks": 0.5 * jax.random.normal(ks[8], (n_even, N_HEADS_B), jnp.float32),
        "w_out_even": nrm(ks[9], (n_even, EVEN_MIX_WIDTH, d), EVEN_MIX_WIDTH),
        "w_in_odd": nrm(ks[10], (n_odd, d, ODD_IN_WIDTH), d),
        "b_forget": jax.random.uniform(ks[11], (n_odd, N_HEADS_C), jnp.float32, 2.0, 6.0),
        "c_q_gain": gain(ks[12], (n_odd, HEAD_DIM)),
        "c_k_gain": gain(ks[13], (n_odd, HEAD_DIM)),
        "w_out_odd": nrm(ks[14], (n_odd, ODD_MIX_WIDTH, d), ODD_MIX_WIDTH),
        "w_up": nrm(ks[15], (DEPTH, d, D_FF), d),
        "w_down": nrm(ks[16], (DEPTH, D_FF, d), D_FF),
    }


def reference(x, g_mix, g_mlp, w_in_even, a_q_gain, a_k_gain, b_q_gain, b_k_gain, b_sinks,
              w_out_even, w_in_odd, b_forget, c_q_gain, c_k_gain, w_out_odd, w_up, w_down):
    for layer in range(DEPTH):
        i = layer // 2
        h = rms_norm(x, g_mix[layer])
        if layer % 2 == 0:
            x = x + even_mixer(h, w_in_even[i], a_q_gain[i], a_k_gain[i], b_q_gain[i],
                               b_k_gain[i], b_sinks[i], w_out_even[i])
        else:
            x = x + odd_mixer(h, w_in_odd[i], b_forget[i], c_q_gain[i], c_k_gain[i], w_out_odd[i])
        h = rms_norm(x, g_mlp[layer])
        x = x + squared_relu_mlp(h, w_up[layer], w_down[layer])
    return x
```

```cpp
#include <hip/hip_runtime.h>
#include <hip/hip_cooperative_groups.h>
#include <cstdio>
#include <cstdint>
#include <cmath>
namespace cg = cooperative_groups;
namespace pg8 {
#define PG8_LAS __attribute__((address_space(3)))
typedef unsigned short bf16_t;
typedef short bf16x8 __attribute__((ext_vector_type(8)));
typedef float f32x4 __attribute__((ext_vector_type(4)));
typedef unsigned u32x4 __attribute__((ext_vector_type(4)));
constexpr int BM = 256, BK = 64, HALF = 128, HTB = HALF * BK * 2  , STAGE_BYTES = 8 * HTB, NXCD = 8, WGM = 8;

__host__ __device__ __forceinline__ int lds_byte(int r, int c) { const int st = (r >> 4) * 2 + (c >> 5), rr = r & 15, cc = c & 31, ob = rr * 64 + cc * 2; return st * 1024 + (ob ^ (((ob >> 9) & 1) << 5)); }
__host__ __device__ __forceinline__ void stage_rc(int b, int& R, int& C) { const int st = b / 1024, sb = b % 1024, swz = sb ^ (((sb >> 9) & 1) << 5); R = (st >> 1) * 16 + swz / 64; C = (st & 1) * 32 + (swz % 64) / 2; }
__host__ __device__ __forceinline__ int perm32(int rho) { const int n = rho >> 4, i = rho & 15; return 8 * (i >> 2) + 4 * n + (i & 3); }

struct Unit { int pm, pn; };
struct Gemm { const bf16_t* A; const bf16_t* Bt; int M, N, K; };

struct StaticOrder {
    int nM, nN, nwg, G, c;
    __host__ __device__ void init(int M, int N, int G_, int c_) { nM = M / BM; nN = N / BM; nwg = nM * nN; G = G_; c = c_; }
    __host__ __device__ bool next(int i, Unit& u) const {
        const long L = (long)i * G + c; if (L >= nwg) return false;
        int wgid = (int)L; { const int q = nwg / NXCD, r = nwg % NXCD, xcd = wgid % NXCD, off = wgid / NXCD; wgid = (xcd < r ? xcd * (q + 1) : r * (q + 1) + (xcd - r) * q) + off; }
        const int nig = WGM * nN, gid = wgid / nig, fm = gid * WGM, gsz = (nM - fm) < WGM ? (nM - fm) : WGM;
        u.pm = fm + ((wgid % nig) % gsz); u.pn = (wgid % nig) / gsz; return true;
    }
    __device__ __forceinline__ void a_ready(const Unit&) const {}
    __device__ __forceinline__ void done(const Unit&) const {}
};

__device__ __forceinline__ unsigned cvt_pk_bf16(float lo, float hi) { unsigned r; asm volatile("v_cvt_pk_bf16_f32 %0, %1, %2" : "=v"(r) : "v"(lo), "v"(hi)); return r; }
typedef float f32x2 __attribute__((ext_vector_type(2)));
template <class Epi, class Sched, bool ALIGN_EPI = false, bool SP2 = false>
__device__ __forceinline__ void gemm_phase(PG8_LAS unsigned char* lds, const Gemm g, const Sched& S, const Epi& E) {
    int tid_ = threadIdx.x; asm volatile("" : "+v"(tid_));
    const int tid = tid_, wid = __builtin_amdgcn_readfirstlane(tid >> 6), lane = tid & 63, wr = wid >> 2, wc = wid & 3, fr = lane & 15, fq = lane >> 4;
    const int K = g.K, nt = K / BK;
    unsigned voffA[2], voffB[2];
#pragma unroll
    for (int i = 0; i < 2; ++i) { int R, C; stage_rc(tid * 16 + i * 8192, R, C); const int Rb = Epi::PERM ? ((R & ~31) + perm32(R & 31)) : R;
        voffA[i] = (unsigned)(R * K + C) * 2u; voffB[i] = (unsigned)(Rb * K + C) * 2u; }
    const size_t kstep = (size_t)(BK * 2);
    const size_t hstep = (size_t)HALF * K * 2;
    const size_t tstep = 2 * hstep;
    const unsigned ldsw = (unsigned)wid * 1024u;
    const int aoff = lds_byte(wr * 64 + fr, fq * 8), boff = lds_byte(wc * 32 + fr, fq * 8);
#define PG8_SA(b, h) (((b) * 2 + (h)) * HTB)
#define PG8_SB(b, h) ((4 + (b) * 2 + (h)) * HTB)
#define PG8_STAGE(bufoff, gbase, voff) do { _Pragma("unroll") for (int _i = 0; _i < 2; ++_i) \
        __builtin_amdgcn_global_load_lds((const unsigned*)((const char*)(gbase) + (voff)[_i]), (PG8_LAS unsigned*)(lds + (bufoff) + ldsw + _i * 8192), 16, 0, 0); } while (0)
#define PG8_LDA(dst, b, h) do { _Pragma("unroll") for (int m = 0; m < 4; ++m) _Pragma("unroll") for (int k = 0; k < 2; ++k) dst[m][k] = *(const PG8_LAS bf16x8*)(lds + PG8_SA(b, h) + aoff + m * 2048 + k * 1024); } while (0)
#define PG8_LDB(dst, b, h) do { _Pragma("unroll") for (int n = 0; n < 2; ++n) _Pragma("unroll") for (int k = 0; k < 2; ++k) dst[n][k] = *(const PG8_LAS bf16x8*)(lds + PG8_SB(b, h) + boff + n * 2048 + k * 1024); } while (0)
#define PG8_MMA(ai, bj, At, Bt) do { __builtin_amdgcn_s_setprio(1); _Pragma("unroll") for (int m = 0; m < 4; ++m) _Pragma("unroll") for (int n = 0; n < 2; ++n) _Pragma("unroll") for (int k = 0; k < 2; ++k) \
        acc[ai][bj][m][n] = __builtin_amdgcn_mfma_f32_16x16x32_bf16(Bt[n][k], At[m][k], acc[ai][bj][m][n], 0, 0, 0); __builtin_amdgcn_s_setprio(0); } while (0)
#define PG8_WAIT_V(n) asm volatile("s_waitcnt vmcnt(" #n ")" ::: "memory")
#define PG8_WAIT_L(n) asm volatile("s_waitcnt lgkmcnt(" #n ")" ::: "memory")
#define PG8_BAR __builtin_amdgcn_s_barrier()
#define PG8_SCHED __builtin_amdgcn_sched_barrier(0)
    Unit cur, nxt; int ui = 0;
    if (!S.next(0, cur)) return;
    f32x4 acc[2][2][4][2];
#pragma unroll
    for (int a = 0; a < 2; ++a)
#pragma unroll
        for (int b = 0; b < 2; ++b)
#pragma unroll
            for (int m = 0; m < 4; ++m)
#pragma unroll
                for (int n = 0; n < 2; ++n) acc[a][b][m][n] = (f32x4){0.f, 0.f, 0.f, 0.f};
    bf16x8 At[4][2], B0[2][2], B1[2][2];
    const char* cA = (const char*)g.A + (size_t)cur.pm * tstep; const char* cB = (const char*)g.Bt + (size_t)cur.pn * tstep;
    S.a_ready(cur);
    if constexpr (SP2) {
        PG8_STAGE(PG8_SB(0, 0), cB, voffB); PG8_STAGE(PG8_SB(0, 1), cB + hstep, voffB); PG8_STAGE(PG8_SA(0, 0), cA, voffA); PG8_STAGE(PG8_SA(0, 1), cA + hstep, voffA);
        if (wr == 1) PG8_BAR;
        PG8_WAIT_V(2); PG8_BAR;
        PG8_STAGE(PG8_SB(1, 0), cB + kstep, voffB); PG8_STAGE(PG8_SA(1, 0), cA + kstep, voffA); PG8_STAGE(PG8_SB(1, 1), cB + hstep + kstep, voffB);
        PG8_WAIT_V(6); PG8_BAR;
    } else {
        PG8_STAGE(PG8_SB(0, 0), cB, voffB); PG8_STAGE(PG8_SA(0, 0), cA, voffA); PG8_STAGE(PG8_SB(0, 1), cB + hstep, voffB); PG8_STAGE(PG8_SA(0, 1), cA + hstep, voffA);
        if (wr == 1) PG8_BAR;
        PG8_WAIT_V(4); PG8_BAR;
        PG8_STAGE(PG8_SB(1, 0), cB + kstep, voffB); PG8_STAGE(PG8_SA(1, 0), cA + kstep, voffA); PG8_STAGE(PG8_SB(1, 1), cB + hstep + kstep, voffB);
        PG8_WAIT_V(6); PG8_BAR;
    }
    for (;;) {
        const bool has_next = S.next(ui + 1, nxt);
        const char* nA = has_next ? (const char*)g.A + (size_t)nxt.pm * tstep : cA; const char* nB = has_next ? (const char*)g.Bt + (size_t)nxt.pn * tstep : cB;
        for (int t = 0; t < nt; t += 2) {
            const bool last = (t == nt - 2);
            const char* a1 = cA + (size_t)(t + 1) * kstep;
            const char* a2 = last ? nA : cA + (size_t)(t + 2) * kstep; const char* b2 = last ? nB : cB + (size_t)(t + 2) * kstep;
            const char* a3 = a2 + kstep; const char* b3 = b2 + kstep;
            if (last && has_next) S.a_ready(nxt);
            if constexpr (SP2) {
            PG8_LDB(B0, 0, 0); PG8_LDB(B1, 0, 1); PG8_SCHED; PG8_LDA(At, 0, 0); PG8_STAGE(PG8_SA(1, 1), a1 + hstep, voffA);
            PG8_WAIT_V(8); PG8_WAIT_L(0); PG8_BAR; PG8_MMA(0, 0, At, B0); PG8_MMA(0, 1, At, B1); PG8_BAR; PG8_SCHED;
            PG8_LDA(At, 0, 1); PG8_STAGE(PG8_SB(0, 0), b2, voffB); PG8_STAGE(PG8_SB(0, 1), b2 + hstep, voffB); PG8_STAGE(PG8_SA(0, 0), a2, voffA);
            PG8_WAIT_V(8); PG8_WAIT_L(0); PG8_BAR; PG8_MMA(1, 0, At, B0); PG8_MMA(1, 1, At, B1); PG8_BAR; PG8_SCHED;
            PG8_LDB(B0, 1, 0); PG8_LDB(B1, 1, 1); PG8_SCHED; PG8_LDA(At, 1, 0); PG8_STAGE(PG8_SA(0, 1), a2 + hstep, voffA);
            PG8_WAIT_V(8); PG8_WAIT_L(0); PG8_BAR; PG8_MMA(0, 0, At, B0); PG8_MMA(0, 1, At, B1); PG8_BAR; PG8_SCHED;
            PG8_LDA(At, 1, 1); PG8_STAGE(PG8_SB(1, 0), b3, voffB); PG8_STAGE(PG8_SB(1, 1), b3 + hstep, voffB); PG8_STAGE(PG8_SA(1, 0), a3, voffA);
            PG8_WAIT_V(8); PG8_WAIT_L(0); PG8_BAR; PG8_MMA(1, 0, At, B0); PG8_MMA(1, 1, At, B1); PG8_BAR; PG8_SCHED;
            } else {
            PG8_LDB(B0, 0, 0); PG8_SCHED; PG8_LDA(At, 0, 0); PG8_STAGE(PG8_SA(1, 1), a1 + hstep, voffA);
            PG8_WAIT_L(8); PG8_BAR; PG8_WAIT_L(0); PG8_MMA(0, 0, At, B0); PG8_BAR; PG8_SCHED;
            PG8_LDB(B1, 0, 1); PG8_STAGE(PG8_SB(0, 0), b2, voffB);
            PG8_BAR; PG8_WAIT_L(0); PG8_MMA(0, 1, At, B1); PG8_BAR;
            PG8_LDA(At, 0, 1); PG8_STAGE(PG8_SA(0, 0), a2, voffA);
            PG8_BAR; PG8_WAIT_L(0); PG8_MMA(1, 0, At, B0); PG8_BAR; PG8_SCHED;
            PG8_STAGE(PG8_SB(0, 1), b2 + hstep, voffB);
            PG8_WAIT_V(6); PG8_BAR; PG8_MMA(1, 1, At, B1); PG8_BAR;
            PG8_LDB(B0, 1, 0); PG8_SCHED; PG8_LDA(At, 1, 0); PG8_STAGE(PG8_SA(0, 1), a2 + hstep, voffA);
            PG8_WAIT_L(8); PG8_BAR; PG8_WAIT_L(0); PG8_MMA(0, 0, At, B0); PG8_BAR; PG8_SCHED;
            PG8_LDB(B1, 1, 1); PG8_STAGE(PG8_SB(1, 0), b3, voffB);
            PG8_BAR; PG8_WAIT_L(0); PG8_MMA(0, 1, At, B1); PG8_BAR;
            PG8_LDA(At, 1, 1); PG8_STAGE(PG8_SA(1, 0), a3, voffA);
            PG8_BAR; PG8_WAIT_L(0); PG8_MMA(1, 0, At, B0); PG8_BAR; PG8_SCHED;
            PG8_STAGE(PG8_SB(1, 1), b3 + hstep, voffB);
            PG8_WAIT_V(6); PG8_BAR; PG8_MMA(1, 1, At, B1); PG8_BAR;
            }
        }
        if constexpr (ALIGN_EPI) { if (wr == 0) PG8_BAR; }
        if constexpr (!Epi::AFTER_DRAIN) { E(acc, cur, wr, wc, fr, fq); S.done(cur); }
        if (!has_next) break;
#pragma unroll
        for (int a = 0; a < 2; ++a)
#pragma unroll
            for (int b = 0; b < 2; ++b)
#pragma unroll
                for (int m = 0; m < 4; ++m)
#pragma unroll
                    for (int n = 0; n < 2; ++n) acc[a][b][m][n] = (f32x4){0.f, 0.f, 0.f, 0.f};
        cur = nxt; cA = nA; cB = nB; ++ui;
        if constexpr (ALIGN_EPI) { if (wr == 1) PG8_BAR; }
    }
    PG8_WAIT_V(0);
    if constexpr (!ALIGN_EPI) { if (wr == 0) PG8_BAR; }
    PG8_BAR;
    if constexpr (Epi::AFTER_DRAIN) { E.fused(acc, cur, wr, wc, fr, fq, lds, wid, lane); S.done(cur); }
#undef PG8_SA
#undef PG8_SB
#undef PG8_STAGE
#undef PG8_LDA
#undef PG8_LDB
#undef PG8_MMA
#undef PG8_WAIT_V
#undef PG8_WAIT_L
#undef PG8_BAR
#undef PG8_SCHED
}
}

#define LAS __attribute__((address_space(3)))
typedef pg8::bf16_t bf16_t;
typedef pg8::f32x4 f32x4;
typedef pg8::u32x4 u32x4;
typedef pg8::bf16x8 bf16x8;
typedef float f32x16 __attribute__((ext_vector_type(16)));
typedef short s16x4 __attribute__((ext_vector_type(4)));
typedef unsigned u32x2 __attribute__((ext_vector_type(2)));
using pg8::cvt_pk_bf16;

constexpr int BATCH = 8, SEQ = 8192, DM = 1024, MTOK = BATCH * SEQ, DFF = 4096;
constexpr int N_INE = 2304, N_INO = 3088, N_INO_PAD = 3328, LD_E = 2304, LD_O = 3072;
constexpr float EPS = 1e-6f, LOG2E = 1.4426950408889634f, QSCALE = 0.125f * 1.4426950408889634f;
constexpr size_t MiB = (size_t)1 << 20;
constexpr size_t WS_WINE = 0, WS_WOUTE = 5 * MiB, WS_WINO = 7 * MiB, WS_WOUTO = 14 * MiB, WS_WUP = 16 * MiB, WS_WDN = 32 * MiB;
constexpr size_t WS_SSQ = 48 * MiB, WS_LOGF = 52 * MiB, WS_KAUG = 56 * MiB, WS_SCR = 72 * MiB, WS_XB = 144 * MiB, WS_R = 272 * MiB, WS_Y = WS_R + 384 * MiB, WS_CTL = 784 * MiB, WS_END = 785 * MiB;
constexpr int SCR_FLOATS = 2 * 512 * 64 + 2 * 512 * 2;
constexpr int LDS_BYTES = 131072;
constexpr int NPHASE = 13;

struct Params { const float* in[17]; float* out; unsigned char* ws; int lo, hi; };

__device__ __forceinline__ unsigned f2bf(float f) { unsigned u = __builtin_bit_cast(unsigned, f); return (u + 0x7fffu + ((u >> 16) & 1u)) >> 16; }
__device__ __forceinline__ float bf2f(unsigned b) { return __builtin_bit_cast(float, b << 16); }
__device__ __forceinline__ float wave_sum(float v) {
#pragma unroll
    for (int o = 1; o < 64; o <<= 1) v += __shfl_xor(v, o);
    return v;
}
#define LDS_WAIT() asm volatile("s_waitcnt lgkmcnt(0)" ::: "memory")
__device__ __forceinline__ float xadd16(float v) { auto rr = __builtin_amdgcn_permlane16_swap(__float_as_uint(v), __float_as_uint(v), false, false); return __uint_as_float(rr[0]) + __uint_as_float(rr[1]); }
__device__ __forceinline__ float xadd32(float v) { auto rr = __builtin_amdgcn_permlane32_swap(__float_as_uint(v), __float_as_uint(v), false, false); return __uint_as_float(rr[0]) + __uint_as_float(rr[1]); }
__device__ __forceinline__ float xmax32(float v) { auto rr = __builtin_amdgcn_permlane32_swap(__float_as_uint(v), __float_as_uint(v), false, false); return fmaxf(__uint_as_float(rr[0]), __uint_as_float(rr[1])); }

__device__ __forceinline__ void rows_rstd(const float* ssq, int row0, int fq, float (&rs)[2][4]) {
    f32x4 t[2][4];
#pragma unroll
    for (int ai = 0; ai < 2; ++ai)
#pragma unroll
        for (int m = 0; m < 4; ++m) t[ai][m] = *(const f32x4*)(ssq + (size_t)(row0 + ai * 128 + m * 16) * 16 + 4 * fq);
#pragma unroll
    for (int ai = 0; ai < 2; ++ai)
#pragma unroll
        for (int m = 0; m < 4; ++m) { float q = (t[ai][m][0] + t[ai][m][1]) + (t[ai][m][2] + t[ai][m][3]); q = xadd32(xadd16(q)); rs[ai][m] = 1.0f / sqrtf(q * (1.0f / 1024.0f) + EPS); }
}
__device__ __forceinline__ float log_sigmoid(float x) { return x >= 0.f ? -log1pf(expf(-x)) : x - log1pf(expf(x)); }

template <int ODD> struct EpiIn {
    static constexpr bool PERM = true, AFTER_DRAIN = false;
    bf16_t* O; const float* ssq; const float* g0; const float* g1; const float* g2; const float* g3; float* logf; const float* bfg;
    __device__ __forceinline__ void operator()(const f32x4 (&acc)[2][2][4][2], const pg8::Unit& u, int wr, int wc, int fr, int fq) const {
        const int hg = u.pn * 4 + wc;
        int cls = 0; const float* gp = nullptr;
        if (ODD) { if (hg < 16) { cls = 1; gp = g0; } else if (hg < 32) { cls = 2; gp = g1; } else if (hg < 48) cls = 0; else cls = 3; }
        else { if (hg < 8) { cls = 1; gp = g0; } else if (hg < 16) { cls = 2; gp = g1; } else if (hg < 24) cls = 0; else if (hg < 32) { cls = 1; gp = g2; } else if (hg < 34) { cls = 2; gp = g3; } else cls = 0; }
        f32x4 gv[2][2];
#pragma unroll
        for (int bj = 0; bj < 2; ++bj)
#pragma unroll
            for (int n = 0; n < 2; ++n) gv[bj][n] = gp ? *(const f32x4*)(gp + 32 * bj + 8 * fq + 4 * n) : (f32x4){1.f, 1.f, 1.f, 1.f};
        const float qs = (cls == 1) ? QSCALE : 1.f;
        float rs[2][4]; rows_rstd(ssq, u.pm * 256 + wr * 64 + fr, fq, rs);
#pragma unroll
        for (int ai = 0; ai < 2; ++ai)
#pragma unroll
            for (int m = 0; m < 4; ++m) {
                const int row = u.pm * 256 + ai * 128 + wr * 64 + m * 16 + fr;
                const float rstd = rs[ai][m];
                f32x4 v[2][2];
#pragma unroll
                for (int bj = 0; bj < 2; ++bj)
#pragma unroll
                    for (int n = 0; n < 2; ++n) v[bj][n] = acc[ai][bj][m][n] * rstd;
                if (ODD && cls == 3) {
                    if (wc == 0 && fq < 2) {
#pragma unroll
                        for (int n = 0; n < 2; ++n)
#pragma unroll
                            for (int i = 0; i < 4; ++i) { const int hf = 8 * fq + 4 * n + i; logf[(size_t)row * 16 + hf] = log_sigmoid(v[0][n][i] + bfg[hf]); }
                    }
                    continue;
                }
                if (cls == 1 || cls == 2) {
                    float q = 0.f;
#pragma unroll
                    for (int bj = 0; bj < 2; ++bj)
#pragma unroll
                        for (int n = 0; n < 2; ++n) { const f32x4 x = v[bj][n]; q += (x[0] * x[0] + x[1] * x[1]) + (x[2] * x[2] + x[3] * x[3]); }
                    q = xadd32(xadd16(q));
                    const float r = qs / sqrtf(q * (1.0f / 64.0f) + EPS);
#pragma unroll
                    for (int bj = 0; bj < 2; ++bj)
#pragma unroll
                        for (int n = 0; n < 2; ++n) v[bj][n] = v[bj][n] * r * gv[bj][n];
                }
                bf16_t* rowp = O + ((size_t)hg * MTOK + (size_t)row) * 64 + 8 * fq;
#pragma unroll
                for (int bj = 0; bj < 2; ++bj) { u32x4 w; w.x = cvt_pk_bf16(v[bj][0][0], v[bj][0][1]); w.y = cvt_pk_bf16(v[bj][0][2], v[bj][0][3]); w.z = cvt_pk_bf16(v[bj][1][0], v[bj][1][1]); w.w = cvt_pk_bf16(v[bj][1][2], v[bj][1][3]);
                    __builtin_nontemporal_store(w, (u32x4*)(rowp + 32 * bj)); }
            }
    }
};
template <bool RES_F32, bool LAST> struct EpiRes {
    static constexpr bool PERM = true, AFTER_DRAIN = false;
    const float* res; float* out; bf16_t* xb; float* ssq;
    __device__ __forceinline__ void operator()(const f32x4 (&acc)[2][2][4][2], const pg8::Unit& u, int wr, int wc, int fr, int fq) const {
        const int col0 = u.pn * 256 + wc * 32 + 8 * fq;
#pragma unroll
        for (int ai = 0; ai < 2; ++ai) {
            f32x4 rr[4][2][2];
#pragma unroll
            for (int m = 0; m < 4; ++m)
#pragma unroll
                for (int bj = 0; bj < 2; ++bj) { const size_t off = (size_t)(u.pm * 256 + ai * 128 + wr * 64 + m * 16 + fr) * DM + col0 + bj * 128;
                    if (RES_F32) { rr[m][bj][0] = *(const f32x4*)(res + off); rr[m][bj][1] = *(const f32x4*)(res + off + 4); }
                    else { const u32x4 w = *(const u32x4*)(xb + off);
                        rr[m][bj][0] = (f32x4){bf2f(w.x & 0xffffu), bf2f(w.x >> 16), bf2f(w.y & 0xffffu), bf2f(w.y >> 16)}; rr[m][bj][1] = (f32x4){bf2f(w.z & 0xffffu), bf2f(w.z >> 16), bf2f(w.w & 0xffffu), bf2f(w.w >> 16)}; } }
            asm volatile("" ::: "memory");
#pragma unroll
            for (int m = 0; m < 4; ++m) {
                const int row = u.pm * 256 + ai * 128 + wr * 64 + m * 16 + fr; float q = 0.f;
#pragma unroll
                for (int bj = 0; bj < 2; ++bj) { const size_t off = (size_t)row * DM + col0 + bj * 128;
                    const f32x4 v0 = acc[ai][bj][m][0] + rr[m][bj][0], v1 = acc[ai][bj][m][1] + rr[m][bj][1];
                    if (LAST) { __builtin_nontemporal_store(v0, (f32x4*)(out + off)); __builtin_nontemporal_store(v1, (f32x4*)(out + off + 4)); }
                    else {
                        q += (v0[0] * v0[0] + v0[1] * v0[1]) + (v0[2] * v0[2] + v0[3] * v0[3]) + (v1[0] * v1[0] + v1[1] * v1[1]) + (v1[2] * v1[2] + v1[3] * v1[3]);
                        u32x4 w; w.x = cvt_pk_bf16(v0[0], v0[1]); w.y = cvt_pk_bf16(v0[2], v0[3]); w.z = cvt_pk_bf16(v1[0], v1[1]); w.w = cvt_pk_bf16(v1[2], v1[3]);
                        *(u32x4*)(xb + off) = w; } }
                if (!LAST) { q = xadd32(xadd16(q)); if (fq == 0) ssq[(size_t)row * 16 + u.pn * 4 + wc] = q; }
            }
        }
    }
};
struct EpiUp {
    static constexpr bool PERM = true, AFTER_DRAIN = false;
    bf16_t* H; const float* ssq;
    __device__ __forceinline__ void operator()(const f32x4 (&acc)[2][2][4][2], const pg8::Unit& u, int wr, int wc, int fr, int fq) const {
        const int col0 = u.pn * 256 + wc * 32 + 8 * fq;
        float rs[2][4]; rows_rstd(ssq, u.pm * 256 + wr * 64 + fr, fq, rs);
#pragma unroll
        for (int ai = 0; ai < 2; ++ai)
#pragma unroll
            for (int m = 0; m < 4; ++m) {
                const int row = u.pm * 256 + ai * 128 + wr * 64 + m * 16 + fr;
                const float rstd = rs[ai][m];
#pragma unroll
                for (int bj = 0; bj < 2; ++bj) {
                    f32x4 v0 = acc[ai][bj][m][0] * rstd, v1 = acc[ai][bj][m][1] * rstd;
#pragma unroll
                    for (int i = 0; i < 4; ++i) { const float a = fmaxf(v0[i], 0.f), b = fmaxf(v1[i], 0.f); v0[i] = a * a; v1[i] = b * b; }
                    u32x4 w; w.x = cvt_pk_bf16(v0[0], v0[1]); w.y = cvt_pk_bf16(v0[2], v0[3]); w.z = cvt_pk_bf16(v1[0], v1[1]); w.w = cvt_pk_bf16(v1[2], v1[3]);
                    __builtin_nontemporal_store(w, (u32x4*)(H + (size_t)row * DFF + col0 + bj * 128)); }
            }
    }
};

__device__ __forceinline__ void tr_item(const float* W, int K, int N, int Npad, bf16_t* WT, const float* gain, bool hp, LAS float* scr, int item, int lane) {
    const int nblk = Npad / 32, kb = item / nblk, nb = item % nblk, k0 = 64 * kb, n0 = 32 * nb;
    const int nn = n0 + (lane & 31); const bool okn = nn < N;
#pragma unroll 8
    for (int i = 0; i < 32; ++i) { const int kk = 2 * i + (lane >> 5); float v = okn ? W[(size_t)(k0 + kk) * N + nn] : 0.f; if (gain) v *= gain[k0 + kk]; scr[kk * 33 + (lane & 31)] = v; }
    LDS_WAIT();
    int r0 = n0; if (hp) { const int pn = n0 >> 8, w = (n0 >> 6) & 3, bj = (n0 >> 5) & 1; r0 = pn * 256 + bj * 128 + w * 32; }
    const int c = lane & 7;
#pragma unroll
    for (int j = 0; j < 4; ++j) { const int n = (lane >> 3) + 8 * j; const LAS float* s = scr + (8 * c) * 33 + n;
        u32x4 o; o.x = cvt_pk_bf16(s[0 * 33], s[1 * 33]); o.y = cvt_pk_bf16(s[2 * 33], s[3 * 33]); o.z = cvt_pk_bf16(s[4 * 33], s[5 * 33]); o.w = cvt_pk_bf16(s[6 * 33], s[7 * 33]);
        *(u32x4*)(WT + (size_t)(r0 + n) * K + k0 + 8 * c) = o; }
    LDS_WAIT();
}
__device__ __forceinline__ void phase_prologue(const Params& p, LAS unsigned char* lds, int wave, int lane) {
    LAS float* scr = (LAS float*)(lds + wave * 16384);
    const int gw = blockIdx.x * 8 + wave, NGW = gridDim.x * 8;
    constexpr int I_INE = 16 * (N_INE / 32), I_OUT = 16 * 32, I_INO = 16 * (N_INO_PAD / 32), I_UP = 16 * 128, I_DN = 64 * 32;
    constexpr int NIT = I_INE + 2 * I_OUT + I_INO + 2 * I_UP + 2 * I_DN;
    unsigned char* ws = p.ws;
    for (int it = gw; it < NIT; it += NGW) {
        int r = it;
        if (r < I_INE) { tr_item(p.in[3], DM, N_INE, N_INE, (bf16_t*)(ws + WS_WINE), p.in[1], true, scr, r, lane); continue; } r -= I_INE;
        if (r < I_OUT) { tr_item(p.in[9], DM, DM, DM, (bf16_t*)(ws + WS_WOUTE), nullptr, false, scr, r, lane); continue; } r -= I_OUT;
        if (r < I_INO) { tr_item(p.in[10], DM, N_INO, N_INO_PAD, (bf16_t*)(ws + WS_WINO), p.in[1] + DM, true, scr, r, lane); continue; } r -= I_INO;
        if (r < I_OUT) { tr_item(p.in[14], DM, DM, DM, (bf16_t*)(ws + WS_WOUTO), nullptr, false, scr, r, lane); continue; } r -= I_OUT;
        if (r < 2 * I_UP) { const int l = r / I_UP; r -= l * I_UP; tr_item(p.in[15] + (size_t)l * DM * DFF, DM, DFF, DFF, (bf16_t*)(ws + WS_WUP) + (size_t)l * DM * DFF, p.in[2] + l * DM, false, scr, r, lane); continue; } r -= 2 * I_UP;
        { const int l = r / I_DN; r -= l * I_DN; tr_item(p.in[16] + (size_t)l * DM * DFF, DFF, DM, DM, (bf16_t*)(ws + WS_WDN) + (size_t)l * DM * DFF, nullptr, false, scr, r, lane); }
    }
    const float* x = p.in[0]; bf16_t* xb = (bf16_t*)(ws + WS_XB); float* ssq = (float*)(ws + WS_SSQ);
    for (int m = gw; m < MTOK; m += NGW) {
        const f32x4* xr = (const f32x4*)(x + (size_t)m * DM) + lane; f32x4 v[4]; float s = 0.f;
#pragma unroll
        for (int j = 0; j < 4; ++j) { v[j] = xr[64 * j]; s += (v[j].x * v[j].x + v[j].y * v[j].y) + (v[j].z * v[j].z + v[j].w * v[j].w); }
        s = wave_sum(s);
        u32x2* o8 = (u32x2*)(xb + (size_t)m * DM) + lane;
#pragma unroll
        for (int j = 0; j < 4; ++j) { u32x2 w; w.x = cvt_pk_bf16(v[j].x, v[j].y); w.y = cvt_pk_bf16(v[j].z, v[j].w); o8[64 * j] = w; }
        if (lane < 16) ssq[(size_t)m * 16 + lane] = (lane == 0) ? s : 0.f;
    }
}

typedef short v4i16_t __attribute__((ext_vector_type(4)));
__device__ __forceinline__ s16x4 tr_read(LAS const unsigned char* p) { return __builtin_bit_cast(s16x4, __builtin_amdgcn_ds_read_tr16_b64_v4i16((LAS v4i16_t*)p)); }
constexpr int VP = 192;
__device__ __forceinline__ bf16x8 vt_frag(LAS const unsigned char* p) {
    const s16x4 lo = tr_read(p), hi = tr_read(p + 8 * VP);
    return (bf16x8){lo[0], lo[1], lo[2], lo[3], hi[0], hi[1], hi[2], hi[3]};
}
__device__ __forceinline__ bf16x8 pack8(const f32x16& p, int b) {
    u32x4 w; w.x = cvt_pk_bf16(p[b + 0], p[b + 1]); w.y = cvt_pk_bf16(p[b + 2], p[b + 3]); w.z = cvt_pk_bf16(p[b + 4], p[b + 5]); w.w = cvt_pk_bf16(p[b + 6], p[b + 7]);
    return __builtin_bit_cast(bf16x8, w);
}
__device__ __forceinline__ float max3f(float a, float b, float c) { float r; asm("v_max3_f32 %0, %1, %2, %3" : "=v"(r) : "v"(a), "v"(b), "v"(c)); return r; }
#define MFMA32(a, b, c) __builtin_amdgcn_mfma_f32_32x32x16_bf16((a), (b), (c), 0, 0, 0)

__device__ __forceinline__ void win_tile(const bf16_t* Q, const bf16_t* K, const bf16_t* V, size_t rowb, int t0, int stride, int W, float slope2, float m_init, float l_init,
                                         LAS unsigned char* vl, int lane, f32x16 (&o)[2], float& m_out, float& l_out) {
    const int r32 = lane & 31, hi = lane >> 5;
    const bf16_t* qp = Q + (rowb + (size_t)(t0 + r32 * stride)) * LD_E + 8 * hi;
    bf16x8 qf[4];
#pragma unroll
    for (int d0 = 0; d0 < 4; ++d0) qf[d0] = *(const bf16x8*)(qp + 16 * d0);
    const unsigned vlane = (unsigned)((4 * hi + ((lane >> 2) & 3)) * VP + (16 * ((lane >> 4) & 1) + 4 * (lane & 3)) * 2);
    LAS const unsigned char* vb = vl + vlane;
    float bt[16];
#pragma unroll
    for (int r = 0; r < 16; ++r) bt[r] = slope2 * (float)((r & 3) + 8 * (r >> 2) + 4 * hi);
    const float rowc = slope2 * (float)r32;
    float m = m_init + rowc, l = l_init;
#pragma unroll
    for (int r = 0; r < 16; ++r) { o[0][r] = 0.f; o[1][r] = 0.f; }
    bf16x8 kf[4]; u32x4 vr[4];
#define WT_LOAD(KT, KF, VR) do { const int rel0_ = ((KT) - 4) * 32; int tk_ = t0 + (rel0_ + r32) * stride; tk_ = tk_ < 0 ? 0 : tk_; const bf16_t* kp_ = K + (rowb + (size_t)tk_) * LD_E + 8 * hi; \
        _Pragma("unroll") for (int d0 = 0; d0 < 4; ++d0) KF[d0] = *(const bf16x8*)(kp_ + 16 * d0); \
        _Pragma("unroll") for (int i = 0; i < 4; ++i) { const int ci = lane + 64 * i, row = ci >> 3, c16 = ci & 7; int tv = t0 + (rel0_ + row) * stride; tv = tv < 0 ? 0 : tv; VR[i] = *(const u32x4*)(V + (rowb + (size_t)tv) * LD_E + 8 * c16); } } while (0)
    WT_LOAD(4, kf, vr);
#pragma unroll 1
    for (int kt = 4; kt >= 0; --kt) {
        const int rel0 = (kt - 4) * 32;
#pragma unroll
        for (int i = 0; i < 4; ++i) { const int ci = lane + 64 * i, row = ci >> 3, c16 = ci & 7; *(LAS u32x4*)(vl + row * VP + c16 * 16) = vr[i]; }
        asm volatile("" ::: "memory");
        bf16x8 kn[4]; u32x4 vn[4];
        { const int ktn = kt > 0 ? kt - 1 : 0; WT_LOAD(ktn, kn, vn); }
        f32x16 p;
#pragma unroll
        for (int r = 0; r < 16; ++r) p[r] = 0.f;
#pragma unroll
        for (int d0 = 0; d0 < 4; ++d0) p = MFMA32(kf[d0], qf[d0], p);
        const float cb = slope2 * (float)rel0;
        float mx = -INFINITY;
        if (kt == 4 || kt == 0 || (t0 + rel0 * stride < 0)) {
#pragma unroll
            for (int r = 0; r < 16; ++r) { const int kv = (r & 3) + 8 * (r >> 2) + 4 * hi; const int dist = r32 - rel0 - kv; const int tkk = t0 + (rel0 + kv) * stride;
                const bool ok = (dist >= 0) && (dist <= W) && (tkk >= 0);
                p[r] = ok ? p[r] + (bt[r] + cb) : -INFINITY; mx = fmaxf(mx, p[r]); }
        } else {
#pragma unroll
            for (int r = 0; r < 16; ++r) { p[r] = p[r] + (bt[r] + cb); mx = fmaxf(mx, p[r]); }
        }
        mx = xmax32(mx);
        const float mn = fmaxf(m, mx);
        if (__any(mn > m)) {
            const float alpha = __builtin_amdgcn_exp2f(m - mn); l *= alpha;
#pragma unroll
            for (int r = 0; r < 16; ++r) { o[0][r] *= alpha; o[1][r] *= alpha; }
        }
        m = mn;
        float rs = 0.f;
#pragma unroll
        for (int r = 0; r < 16; ++r) { p[r] = __builtin_amdgcn_exp2f(p[r] - mn); rs += p[r]; }
        l += rs;
        const bf16x8 pb0 = pack8(p, 0), pb1 = pack8(p, 8);
#pragma unroll
        for (int dblk = 0; dblk < 2; ++dblk) {
            const bf16x8 a0 = vt_frag(vb + dblk * 64), a1 = vt_frag(vb + 16 * VP + dblk * 64);
            o[dblk] = MFMA32(a0, pb0, o[dblk]); o[dblk] = MFMA32(a1, pb1, o[dblk]);
        }
        asm volatile("" ::: "memory");
#pragma unroll
        for (int d0 = 0; d0 < 4; ++d0) kf[d0] = kn[d0];
#pragma unroll
        for (int i = 0; i < 4; ++i) vr[i] = vn[i];
    }
#undef WT_LOAD
    m_out = m - rowc; l_out = l;
}
__device__ __forceinline__ void store_o4(bf16_t* dst, float a, float b, float c, float d) { u32x2 w; w.x = cvt_pk_bf16(a, b); w.y = cvt_pk_bf16(c, d); *(u32x2*)dst = w; }

__device__ __forceinline__ void phase_win(const Params& p, LAS unsigned char* lds, int wave, int lane) {
    const bf16_t* QKV = (const bf16_t*)(p.ws + WS_R); bf16_t* Y = (bf16_t*)(p.ws + WS_Y);
    float* scr = (float*)(p.ws + WS_SCR) + (size_t)blockIdx.x * SCR_FLOATS; float* scml = scr + 2 * 512 * 64;
    LAS unsigned char* vl = lds + wave * 6144;
    const int r32 = lane & 31, hi = lane >> 5;
    const int G = gridDim.x, vcu = (G % 8 == 0) ? ((int)blockIdx.x % 8) * (G / 8) + (int)blockIdx.x / 8 : (int)blockIdx.x;
    for (int u = vcu; u < 1024; u += G) {
        const int span = u & 15, head = (u >> 4) & 7, b = u >> 7, T0 = span * 512; const size_t rowb = (size_t)b * SEQ;
        const float slope = exp2f(-0.5f * (float)(9 + head));
        const bf16_t *Qh = QKV + 64 * head, *Kh = QKV + 512 + 64 * head, *Vh = QKV + 1024 + 64 * head;
        for (int tt = wave; tt < 32; tt += 8) {
            int br, stride, t0;
            if (tt < 16) { br = 0; stride = 16; t0 = T0 + tt; } else { const int t4 = tt - 16; br = 1; stride = 4; t0 = T0 + (t4 & 3) + 128 * (t4 >> 2); }
            f32x16 o[2]; float m, l;
            win_tile(Qh, Kh, Vh, rowb, t0, stride, 128, slope * (float)stride * LOG2E, -INFINITY, 0.f, vl, lane, o, m, l);
            l += __shfl_xor(l, 32);
            const int tis = (t0 - T0) + r32 * stride;
            float* op = scr + ((size_t)br * 512 + tis) * 64 + 4 * hi;
#pragma unroll
            for (int dblk = 0; dblk < 2; ++dblk)
#pragma unroll
                for (int rg = 0; rg < 4; ++rg) *(f32x4*)(op + 32 * dblk + 8 * rg) = (f32x4){o[dblk][4 * rg], o[dblk][4 * rg + 1], o[dblk][4 * rg + 2], o[dblk][4 * rg + 3]};
            if (hi == 0) { scml[(br * 512 + tis) * 2] = m; scml[(br * 512 + tis) * 2 + 1] = l; }
        }
        __syncthreads();
        for (int tt = wave; tt < 16; tt += 8) {
            const int t0 = T0 + 32 * tt;
            f32x16 o[2]; float m, l;
            win_tile(Qh, Kh, Vh, rowb, t0, 1, 128, slope * LOG2E, -INFINITY, 0.f, vl, lane, o, m, l);
            l += __shfl_xor(l, 32);
            const int tis = 32 * tt + r32;
            const float m16 = scml[tis * 2], l16 = scml[tis * 2 + 1], m4 = scml[(512 + tis) * 2], l4 = scml[(512 + tis) * 2 + 1];
            const float M = fmaxf(m, fmaxf(m16, m4));
            const float w1 = __builtin_amdgcn_exp2f(m - M), w16 = __builtin_amdgcn_exp2f(m16 - M), w4 = __builtin_amdgcn_exp2f(m4 - M);
            const float inv = 1.0f / (l * w1 + l16 * w16 + l4 * w4);
            const float* o16 = scr + (size_t)tis * 64 + 4 * hi; const float* o4 = scr + ((size_t)512 + tis) * 64 + 4 * hi;
            bf16_t* yp = Y + (rowb + (size_t)(t0 + r32)) * DM + 64 * head + 4 * hi;
#pragma unroll
            for (int dblk = 0; dblk < 2; ++dblk)
#pragma unroll
                for (int rg = 0; rg < 4; ++rg) { const f32x4 a = *(const f32x4*)(o16 + 32 * dblk + 8 * rg), c = *(const f32x4*)(o4 + 32 * dblk + 8 * rg);
                    store_o4(yp + 32 * dblk + 8 * rg, (o[dblk][4 * rg] * w1 + a[0] * w16 + c[0] * w4) * inv, (o[dblk][4 * rg + 1] * w1 + a[1] * w16 + c[1] * w4) * inv,
                             (o[dblk][4 * rg + 2] * w1 + a[2] * w16 + c[2] * w4) * inv, (o[dblk][4 * rg + 3] * w1 + a[3] * w16 + c[3] * w4) * inv); }
        }
        __syncthreads();
    }
    const float* sinks = p.in[8];
    for (int u = vcu; u < 2048; u += G) {
        const int blk = (u >> 2) & 31, kvh = (u >> 7) & 1, hq = kvh * 4 + (u & 3), b = u >> 8; const size_t rowb = (size_t)b * SEQ;
        const int t0 = blk * 256 + 32 * wave;
        const float slope = exp2f(-0.5f * (float)(hq + 1)), sink2 = sinks[hq] * LOG2E;
        f32x16 o[2]; float m, l;
        win_tile(QKV + 1536 + 64 * hq, QKV + 2048 + 64 * kvh, QKV + 2176 + 64 * kvh, rowb, t0, 1, 127, slope * LOG2E, sink2, hi == 0 ? 1.f : 0.f, vl, lane, o, m, l);
        l += __shfl_xor(l, 32);
        const float inv = 1.0f / l;
        bf16_t* yp = Y + (rowb + (size_t)(t0 + r32)) * DM + 512 + 64 * hq + 4 * hi;
#pragma unroll
        for (int dblk = 0; dblk < 2; ++dblk)
#pragma unroll
            for (int rg = 0; rg < 4; ++rg) store_o4(yp + 32 * dblk + 8 * rg, o[dblk][4 * rg] * inv, o[dblk][4 * rg + 1] * inv, o[dblk][4 * rg + 2] * inv, o[dblk][4 * rg + 3] * inv);
    }
}

constexpr int KPW = 144;
constexpr size_t WS_OP = 785 * MiB, WS_ML = 913 * MiB, WS_END2 = 921 * MiB;
__device__ __forceinline__ void blk_tile(const bf16x8 (&qf)[4], LAS const unsigned char* Kw, LAS const unsigned char* Vw, int rowoff, int t0w, int stride, int W, float slope2, float m_init, float l_init,
                                         int lane, f32x16 (&o)[2], float& m_out, float& l_out) {
    const int r32 = lane & 31, hi = lane >> 5;
    const unsigned vlane = (unsigned)((4 * hi + ((lane >> 2) & 3)) * VP + (16 * ((lane >> 4) & 1) + 4 * (lane & 3)) * 2);
    const float rowc = slope2 * (float)r32;
    float m = m_init + rowc, l = l_init;
#pragma unroll
    for (int r = 0; r < 16; ++r) { o[0][r] = 0.f; o[1][r] = 0.f; }
#pragma unroll 1
    for (int kt = 4; kt >= 0; --kt) {
        const int rel0 = (kt - 4) * 32;
        LAS const unsigned char* kb = Kw + (rowoff + 32 * kt + r32) * KPW + hi * 16;
        f32x16 p;
#pragma unroll
        for (int r = 0; r < 16; ++r) p[r] = 0.f;
#pragma unroll
        for (int d0 = 0; d0 < 4; ++d0) { const bf16x8 kf = *(LAS const bf16x8*)(kb + d0 * 32); p = MFMA32(kf, qf[d0], p); }
        const float cb = slope2 * (float)(rel0 + 4 * hi);
        float mx = -INFINITY;
        if (kt == 4 || kt == 0 || (t0w + rel0 * stride < 0)) {
#pragma unroll
            for (int r = 0; r < 16; ++r) { const int kv = (r & 3) + 8 * (r >> 2) + 4 * hi; const int dist = r32 - rel0 - kv; const int tkk = t0w + (rel0 + kv) * stride;
                const bool ok = (dist >= 0) && (dist <= W) && (tkk >= 0);
                p[r] = ok ? fmaf(slope2, (float)((r & 3) + 8 * (r >> 2)), p[r] + cb) : -INFINITY; mx = fmaxf(mx, p[r]); }
        } else {
#pragma unroll
            for (int r = 0; r < 16; ++r) { p[r] = fmaf(slope2, (float)((r & 3) + 8 * (r >> 2)), p[r] + cb); mx = fmaxf(mx, p[r]); }
        }
        mx = xmax32(mx);
        const float mn = fmaxf(m, mx);
        if (__any(mn > m)) {
            const float alpha = __builtin_amdgcn_exp2f(m - mn); l *= alpha;
#pragma unroll
            for (int r = 0; r < 16; ++r) { o[0][r] *= alpha; o[1][r] *= alpha; }
        }
        m = mn;
        float rs = 0.f;
#pragma unroll
        for (int r = 0; r < 16; ++r) { p[r] = __builtin_amdgcn_exp2f(p[r] - mn); rs += p[r]; }
        l += rs;
        const bf16x8 pb0 = pack8(p, 0), pb1 = pack8(p, 8);
        LAS const unsigned char* vb = Vw + (rowoff + 32 * kt) * VP + vlane;
#pragma unroll
        for (int dblk = 0; dblk < 2; ++dblk) {
            const bf16x8 a0 = vt_frag(vb + dblk * 64), a1 = vt_frag(vb + 16 * VP + dblk * 64);
            o[dblk] = MFMA32(a0, pb0, o[dblk]); o[dblk] = MFMA32(a1, pb1, o[dblk]);
        }
    }
    m_out = m - rowc; l_out = l;
}
struct WinUnit { int b, head, dil, tq0, nk, kcol, vcol, isB, kvh, br; };
__device__ __forceinline__ WinUnit win_decode(int u, int pass) {
    WinUnit w; w.isB = 0; w.kvh = 0; w.br = 0;
    if (pass == 1) { const int bhd = u >> 5, blk = u & 31; w.b = bhd >> 3; w.head = bhd & 7; w.dil = 1; w.tq0 = 256 * blk; w.nk = 6; w.kcol = 8 + w.head; w.vcol = 16 + w.head; }
    else if (u < 4096) { const int bhd = u >> 6, w6 = u & 63; w.b = bhd >> 3; w.head = bhd & 7;
        if (w6 < 32) { w.dil = 16; w.tq0 = (w6 >> 1) + 16 * 256 * (w6 & 1); w.br = 0; } else { const int x = w6 - 32; w.dil = 4; w.tq0 = (x >> 3) + 4 * 256 * (x & 7); w.br = 1; }
        w.nk = 6; w.kcol = 8 + w.head; w.vcol = 16 + w.head; }
    else { const int v = u - 4096, tb = v & 127; w.kvh = (v >> 7) & 1; w.b = v >> 8; w.head = 0; w.isB = 1; w.dil = 1; w.tq0 = 64 * tb; w.nk = 3; w.kcol = 32 + w.kvh; w.vcol = 34 + w.kvh; }
    return w;
}
struct WinWave { int rowoff, t0w, qcol, hq; };
__device__ __forceinline__ WinWave win_wave(const WinUnit& wu, int wave) {
    WinWave w; w.hq = 0;
    if (wu.isB) { const int g = wave >> 1, j = wave & 1; w.hq = 4 * wu.kvh + g; w.rowoff = 32 * j; w.t0w = wu.tq0 + 32 * j; w.qcol = 24 + w.hq; }
    else { w.rowoff = 32 * wave; w.t0w = wu.tq0 + 32 * wave * wu.dil; w.qcol = wu.head; }
    return w;
}
template <int PASS, int VAR = 0> __device__ __forceinline__ void phase_win2(const Params& p, LAS unsigned char* lds, int tid, int wave, int lane) {
    const bf16_t* QKV = (const bf16_t*)(p.ws + WS_R); bf16_t* Y = (bf16_t*)(p.ws + (VAR ? WS_XB : WS_Y));
    bf16_t* OP = (bf16_t*)(p.ws + WS_OP); float* ML = (float*)(p.ws + WS_ML);
    LAS unsigned char* Kw = lds; LAS unsigned char* Vw = lds + 384 * KPW;
    const int r32 = lane & 31, hi = lane >> 5, srow = tid >> 3, sc16 = tid & 7;
    const int G = gridDim.x, vcu = (G % 8 == 0) ? ((int)blockIdx.x % 8) * (G / 8) + (int)blockIdx.x / 8 : (int)blockIdx.x;
    constexpr int NU = PASS ? 2048 : 6144;
    const float* sinks = p.in[8];
    u32x4 kreg[6], vreg[6]; bf16x8 qn[4];
#define WIN_LOAD(WU) do { const size_t rb_ = (size_t)(WU).b * SEQ; \
        if (VAR != 2) _Pragma("unroll") for (int k = 0; k < 6; ++k) if (k < (WU).nk) { int tk_ = (WU).tq0 + (srow + 64 * k - 128) * (WU).dil; tk_ = tk_ < 0 ? 0 : tk_; \
            const size_t ro_ = (rb_ + (size_t)tk_) * 64 + 8 * sc16; kreg[k] = *(const u32x4*)(QKV + (size_t)(WU).kcol * MTOK * 64 + ro_); vreg[k] = *(const u32x4*)(QKV + (size_t)(WU).vcol * MTOK * 64 + ro_); } \
        const WinWave ww_ = win_wave((WU), wave); const bf16_t* qp_ = QKV + ((size_t)ww_.qcol * MTOK + rb_ + (size_t)(ww_.t0w + r32 * (WU).dil)) * 64 + 8 * hi; \
        _Pragma("unroll") for (int d0 = 0; d0 < 4; ++d0) qn[d0] = *(const bf16x8*)(qp_ + 16 * d0); } while (0)
    int u = vcu;
    if (u < NU) { const WinUnit w0 = win_decode(u, PASS); WIN_LOAD(w0); }
    for (; u < NU; u += G) {
        const WinUnit wu = win_decode(u, PASS);
        const WinWave ww = win_wave(wu, wave);
        const int rowoff = ww.rowoff, t0w = ww.t0w, hq = ww.hq;
        const size_t rowb = (size_t)wu.b * SEQ;
        const int qtok = t0w + r32 * wu.dil;
        const size_t tokrow = rowb + (size_t)qtok;
        bf16x8 qf[4];
#pragma unroll
        for (int d0 = 0; d0 < 4; ++d0) qf[d0] = qn[d0];
#pragma unroll
        for (int k = 0; k < 6; ++k) if (VAR != 2 && k < wu.nk) { *(LAS u32x4*)(Kw + (srow + 64 * k) * KPW + sc16 * 16) = kreg[k]; *(LAS u32x4*)(Vw + (srow + 64 * k) * VP + sc16 * 16) = vreg[k]; }
        asm volatile("s_waitcnt lgkmcnt(0)\n\ts_barrier" ::: "memory");
        if (u + G < NU) { const WinUnit wn = win_decode(u + G, PASS); WIN_LOAD(wn); }
        f32x16 o[2]; float m, l;
        if (PASS == 0 && wu.isB) {
            const float slope = exp2f(-0.5f * (float)(hq + 1)), sink2 = sinks[hq] * LOG2E;
            blk_tile(qf, Kw, Vw, rowoff, t0w, 1, 127, slope * LOG2E, sink2, hi == 0 ? 1.f : 0.f, lane, o, m, l);
            l += __shfl_xor(l, 32);
            const float inv = 1.0f / l;
            bf16_t* yp = Y + tokrow * DM + 512 + 64 * hq + 4 * hi;
#pragma unroll
            for (int dblk = 0; dblk < 2; ++dblk)
#pragma unroll
                for (int rg = 0; rg < 4; ++rg) store_o4(yp + 32 * dblk + 8 * rg, o[dblk][4 * rg] * inv, o[dblk][4 * rg + 1] * inv, o[dblk][4 * rg + 2] * inv, o[dblk][4 * rg + 3] * inv);
        } else if (PASS == 0) {
            const float slope = exp2f(-0.5f * (float)(9 + wu.head));
            blk_tile(qf, Kw, Vw, rowoff, t0w, wu.dil, 128, slope * (float)wu.dil * LOG2E, -INFINITY, 0.f, lane, o, m, l);
            l += __shfl_xor(l, 32);
            const float inv = 1.0f / l;
            bf16_t* op = OP + ((size_t)wu.br * MTOK + tokrow) * 512 + 64 * wu.head + 4 * hi;
#pragma unroll
            for (int dblk = 0; dblk < 2; ++dblk)
#pragma unroll
                for (int rg = 0; rg < 4; ++rg) store_o4(op + 32 * dblk + 8 * rg, o[dblk][4 * rg] * inv, o[dblk][4 * rg + 1] * inv, o[dblk][4 * rg + 2] * inv, o[dblk][4 * rg + 3] * inv);
            if (hi == 0) { float* ml = ML + (((size_t)wu.br * MTOK + tokrow) * 8 + wu.head) * 2; ml[0] = m; ml[1] = l; }
        } else {
            const float* ml16 = ML + (tokrow * 8 + wu.head) * 2; const float* ml4 = ML + (((size_t)MTOK + tokrow) * 8 + wu.head) * 2;
            const float m16 = ml16[0], l16 = ml16[1], m4 = ml4[0], l4 = ml4[1];
            const bf16_t* o16 = OP + tokrow * 512 + 64 * wu.head + 4 * hi; const bf16_t* o4 = OP + ((size_t)MTOK + tokrow) * 512 + 64 * wu.head + 4 * hi;
            u32x2 pa[2][4], pc[2][4];
#pragma unroll
            for (int dblk = 0; dblk < 2; ++dblk)
#pragma unroll
                for (int rg = 0; rg < 4; ++rg) { pa[dblk][rg] = *(const u32x2*)(o16 + 32 * dblk + 8 * rg); pc[dblk][rg] = *(const u32x2*)(o4 + 32 * dblk + 8 * rg); }
            const float slope = exp2f(-0.5f * (float)(9 + wu.head));
            if (VAR != 1) blk_tile(qf, Kw, Vw, rowoff, t0w, 1, 128, slope * LOG2E, -INFINITY, 0.f, lane, o, m, l);
            else { m = 0.f; l = 1.f; _Pragma("unroll") for (int r = 0; r < 16; ++r) { o[0][r] = __builtin_bit_cast(float, qf[0][r & 7] << 16); o[1][r] = o[0][r]; } }
            l += __shfl_xor(l, 32);
            const float M = fmaxf(m, fmaxf(m16, m4));
            float w1 = __builtin_amdgcn_exp2f(m - M), w16 = __builtin_amdgcn_exp2f(m16 - M) * l16, w4 = __builtin_amdgcn_exp2f(m4 - M) * l4;
            const float inv = 1.0f / (l * w1 + w16 + w4); w1 *= inv; w16 *= inv; w4 *= inv;
            bf16_t* yp = Y + tokrow * DM + 64 * wu.head + 4 * hi;
#pragma unroll
            for (int dblk = 0; dblk < 2; ++dblk)
#pragma unroll
                for (int rg = 0; rg < 4; ++rg) { const u32x2 a = pa[dblk][rg], c = pc[dblk][rg];
                    store_o4(yp + 32 * dblk + 8 * rg, o[dblk][4 * rg] * w1 + bf2f(a.x & 0xffffu) * w16 + bf2f(c.x & 0xffffu) * w4, o[dblk][4 * rg + 1] * w1 + bf2f(a.x >> 16) * w16 + bf2f(c.x >> 16) * w4,
                             o[dblk][4 * rg + 2] * w1 + bf2f(a.y & 0xffffu) * w16 + bf2f(c.y & 0xffffu) * w4, o[dblk][4 * rg + 3] * w1 + bf2f(a.y >> 16) * w16 + bf2f(c.y >> 16) * w4); }
        }
        asm volatile("s_waitcnt lgkmcnt(0)\n\ts_barrier" ::: "memory");
    }
#undef WIN_LOAD
}

__device__ __forceinline__ void phase_cumsum(const Params& p, LAS unsigned char* lds, int tid, int wave, int lane) {
    const float* logf = (const float*)(p.ws + WS_LOGF); bf16_t* KA = (bf16_t*)(p.ws + WS_KAUG); float* VF = (float*)(p.ws + WS_SCR);
    LAS double* wsum = (LAS double*)lds;
    for (int bh = blockIdx.x; bh < BATCH * 16; bh += gridDim.x) {
        const int b = bh >> 4, h = bh & 15, s0 = tid * 16;
        float v[16]; double tot = 0.0;
#pragma unroll
        for (int i = 0; i < 16; ++i) { v[i] = logf[((size_t)b * SEQ + s0 + i) * 16 + h]; tot += (double)v[i]; }
        double inc = tot;
#pragma unroll
        for (int o = 1; o < 64; o <<= 1) { const double n = __shfl_up(inc, o); if (lane >= o) inc += n; }
        if (lane == 63) wsum[wave] = inc;
        __syncthreads();
        double base = 0.0;
        for (int w = 0; w < wave; ++w) base += wsum[w];
        __syncthreads();
        double c = base + inc - tot;
#pragma unroll
        for (int i = 0; i < 16; ++i) { c += (double)v[i]; const float val = (float)(-c * 1.4426950408889634);
            const unsigned b0 = f2bf(val); const float r1 = val - bf2f(b0); const unsigned b1 = f2bf(r1); const float r2 = r1 - bf2f(b1); const unsigned b2 = f2bf(r2);
            u32x4 w; w.x = b0 | (b1 << 16); w.y = b2 | (0x3F80u << 16); w.z = 0x3F803F80u; w.w = 0u;
            *(u32x4*)(KA + ((size_t)bh * SEQ + s0 + i) * 8) = w; VF[(size_t)bh * SEQ + s0 + i] = val; }
    }
}

__device__ __forceinline__ void phase_fox(const Params& p, LAS unsigned char* lds, int tid, int wave, int lane, int qidx) {
    const bf16_t* QKV = (const bf16_t*)(p.ws + WS_R); const bf16_t* KA = (const bf16_t*)(p.ws + WS_KAUG); bf16_t* Y = (bf16_t*)(p.ws + WS_Y);
    constexpr int KP = 144, KB_BYTES = 64 * KP, VB_BYTES = 64 * VP;
    constexpr float THR = 16.f;
    LAS unsigned char* Kl = lds; LAS unsigned char* Vl = lds + 2 * KB_BYTES;
    const int r32 = lane & 31, hi = lane >> 5, srow = tid >> 3, sc16 = tid & 7;
    const unsigned vlane = (unsigned)((4 * hi + ((lane >> 2) & 3)) * VP + (16 * ((lane >> 4) & 1) + 4 * (lane & 3)) * 2);
    const float* VF = (const float*)(p.ws + WS_SCR);
    float gqm = 0.f, gkm = 0.f;
    for (int i = 0; i < 64; ++i) { gqm = fmaxf(gqm, fabsf(p.in[12][i])); gkm = fmaxf(gkm, fabsf(p.in[13][i])); }
    const float TH = __uint_as_float(__builtin_amdgcn_readfirstlane(__float_as_uint(2.1f * (64.0f * QSCALE * gqm * gkm) + 150.0f + THR)));
    unsigned* qctr = (unsigned*)(p.ws + WS_CTL) + 64 * qidx;
    LAS int* qslot = (LAS int*)(lds + 2 * KB_BYTES + 2 * VB_BYTES);
    const f32x16 zero16 = {0.f, 0.f, 0.f, 0.f, 0.f, 0.f, 0.f, 0.f, 0.f, 0.f, 0.f, 0.f, 0.f, 0.f, 0.f, 0.f};
#define SB_() __builtin_amdgcn_sched_barrier(0)
#define QKG0(N0, N1) do { const bf16x8 a0_ = *(LAS const bf16x8*)(kb_ + hi * 16), a1_ = *(LAS const bf16x8*)(kb_ + 32 * KP + hi * 16); N0 = MFMA32(a0_, qf[0], zero16); N1 = MFMA32(a1_, qf[0], zero16); } while (0)
#define QKG(D0, N0, N1) do { const bf16x8 a0_ = *(LAS const bf16x8*)(kb_ + hi * 16 + (D0) * 32), a1_ = *(LAS const bf16x8*)(kb_ + 32 * KP + hi * 16 + (D0) * 32); N0 = MFMA32(a0_, qf[D0], N0); N1 = MFMA32(a1_, qf[D0], N1); } while (0)
#define QKA(N0, N1) do { const bf16x8 a0_ = *(LAS const bf16x8*)(kb_ + 128), a1_ = *(LAS const bf16x8*)(kb_ + 32 * KP + 128); N0 = MFMA32(a0_, qaug, N0); N1 = MFMA32(a1_, qaug, N1); } while (0)
#define EXPR(C, LO, HI) do { _Pragma("unroll") for (int r = (LO); r < (HI); ++r) { C[r] = __builtin_amdgcn_exp2f(C[r]); rs_ += C[r]; } } while (0)
#define MAXR(N0, N1, LO, HI) do { _Pragma("unroll") for (int r = (LO); r < (HI); ++r) mx_ = max3f(mx_, N0[r], N1[r]); } while (0)
#define PVG(CC, SRC, BASE) do { const bf16x8 va_ = vt_frag(vb_ + (CC) * 16 * VP), vbb_ = vt_frag(vb_ + (CC) * 16 * VP + 64); const bf16x8 pa_ = pack8(SRC, BASE); o0 = MFMA32(va_, pa_, o0); o1 = MFMA32(vbb_, pa_, o1); } while (0)
#define FOX_MASK(S0, S1, T) do { if ((T) >= NT - 4 && 64 * (T) + 63 > q0 + 32 * wave) { const int kvb_ = 64 * (T) + 4 * hi; \
            _Pragma("unroll") for (int r = 0; r < 16; ++r) { const int kv = kvb_ + (r & 3) + 8 * (r >> 2); if (kv > qtok) S0[r] = -INFINITY; if (kv + 32 > qtok) S1[r] = -INFINITY; } } } while (0)
#define FOX_REREF(S0, S1, MX) do { if (__any((MX) > THR)) { const float dl_ = fmaxf((MX), 0.f); ref += dl_; \
            _Pragma("unroll") for (int r = 0; r < 16; ++r) { S0[r] -= dl_; S1[r] -= dl_; } \
            const float f_ = __builtin_amdgcn_exp2f(-dl_); l *= f_; \
            _Pragma("unroll") for (int r = 0; r < 16; ++r) { o0[r] *= f_; o1[r] *= f_; } \
            const float nv_ = -ref; const unsigned b0_ = f2bf(nv_); const float r1_ = nv_ - bf2f(b0_); const unsigned b1_ = f2bf(r1_); const float r2_ = r1_ - bf2f(b1_); const unsigned b2_ = f2bf(r2_); \
            if (hi == 0) { qaug[3] = (short)b0_; qaug[4] = (short)b1_; qaug[5] = (short)b2_; } } } while (0)
#define FOX_DECIDE(S0, S1, T) do { FOX_MASK(S0, S1, T); float mx_ = fmaxf(S0[0], S1[0]); MAXR(S0, S1, 1, 16); mx_ = xmax32(mx_); FOX_REREF(S0, S1, mx_); } while (0)
#define FOX_STAGE(T) do { const int t_ = (T); \
        if (t_ + 1 < NT) { *(LAS u32x4*)(Vl + ((t_ + 1) & 1) * VB_BYTES + srow * VP + sc16 * 16) = vr; \
            if (t_ + 2 < NT) { *(LAS u32x4*)(Kl + (t_ & 1) * KB_BYTES + srow * KP + sc16 * 16) = kr; if (tid < 64) *(LAS u32x4*)(Kl + (t_ & 1) * KB_BYTES + tid * KP + 128) = ar; } } \
        if (t_ + 2 < NT) { vr = *(const u32x4*)(vg + (size_t)(t_ + 2) * 64 * 64); \
            if (t_ + 3 < NT) { kr = *(const u32x4*)(kg + (size_t)(t_ + 3) * 64 * 64); if (tid < 64) ar = *(const u32x4*)(ag + (size_t)(t_ + 3) * 64 * 8); } } \
        asm volatile("s_waitcnt lgkmcnt(0)\n\ts_barrier" ::: "memory"); } while (0)
#define KLD(X0, X1, D0) do { X0 = *(LAS const bf16x8*)(kb_ + hi * 16 + (D0) * 32); X1 = *(LAS const bf16x8*)(kb_ + 32 * KP + hi * 16 + (D0) * 32); } while (0)
#define KLDA(X0, X1) do { X0 = *(LAS const bf16x8*)(kb_ + 128); X1 = *(LAS const bf16x8*)(kb_ + 32 * KP + 128); } while (0)
#define VLD(X0, X1, CC) do { X0 = vt_frag(vb_ + (CC) * 16 * VP); X1 = vt_frag(vb_ + (CC) * 16 * VP + 64); } while (0)
#define PVM(X0, X1, SRC, BASE) do { const bf16x8 pa_ = pack8(SRC, BASE); o0 = MFMA32(X0, pa_, o0); o1 = MFMA32(X1, pa_, o1); } while (0)
#define FOX_IT(C0, C1, N0, N1, T) do { const int ti_ = (T); float rs_ = 0.f; bf16x8 fa0_, fa1_, fb0_, fb1_; \
        LAS const unsigned char* kb_ = Kl + ((ti_ + 1) & 1) * KB_BYTES + r32 * KP; LAS const unsigned char* vb_ = Vl + (ti_ & 1) * VB_BYTES + vlane; \
        SB_(); KLD(fa0_, fa1_, 0); EXPR(C0, 0, 4); SB_(); \
        KLD(fb0_, fb1_, 1); N0 = MFMA32(fa0_, qf[0], zero16); N1 = MFMA32(fa1_, qf[0], zero16); EXPR(C0, 4, 10);  SB_(); \
        KLD(fa0_, fa1_, 2); N0 = MFMA32(fb0_, qf[1], N0);     N1 = MFMA32(fb1_, qf[1], N1);     EXPR(C0, 10, 16); SB_(); \
        KLD(fb0_, fb1_, 3); N0 = MFMA32(fa0_, qf[2], N0);     N1 = MFMA32(fa1_, qf[2], N1);     EXPR(C1, 0, 6);   SB_(); \
        KLDA(fa0_, fa1_);   N0 = MFMA32(fb0_, qf[3], N0);     N1 = MFMA32(fb1_, qf[3], N1);     EXPR(C1, 6, 12);  SB_(); \
        VLD(fb0_, fb1_, 0); N0 = MFMA32(fa0_, qaug, N0);      N1 = MFMA32(fa1_, qaug, N1);      EXPR(C1, 12, 16); SB_(); \
        l += rs_; \
        VLD(fa0_, fa1_, 1); PVM(fb0_, fb1_, C0, 0); SB_(); \
        float mx_ = fmaxf(N0[0], N1[0]); \
        VLD(fb0_, fb1_, 2); PVM(fa0_, fa1_, C0, 8); MAXR(N0, N1, 1, 6);  SB_(); \
        VLD(fa0_, fa1_, 3); PVM(fb0_, fb1_, C1, 0); MAXR(N0, N1, 6, 11); SB_(); \
        PVM(fa0_, fa1_, C1, 8); MAXR(N0, N1, 11, 16); SB_(); \
        mx_ = xmax32(mx_); FOX_REREF(N0, N1, mx_); \
        FOX_STAGE(ti_); } while (0)
    for (;;) {
        if (tid == 0) *qslot = (int)atomicAdd(qctr, 1u);
        __syncthreads();
        const int unit = *qslot;
        if (unit >= 4096) break;
        const int bh = 16 * (unit >> 9) + (unit & 15), b = bh >> 4, h = bh & 15; const size_t rowb = (size_t)b * SEQ;
        const int qb = 31 - ((unit & 511) >> 4), q0 = qb * 256, NT = 4 * (qb + 1);
        const int qtok = q0 + 32 * wave + r32, wmax = q0 + 32 * wave + 31;
        int T0;
        { const float vq0 = VF[(size_t)bh * SEQ + q0]; int pred = 0; if (tid < NT - 4) pred = (vq0 - VF[(size_t)bh * SEQ + 64 * tid + 63] > TH) ? 1 : 0; T0 = __syncthreads_count(pred); }
        bf16x8 qf[4];
        { const bf16_t* qp = QKV + ((size_t)h * MTOK + rowb + (size_t)qtok) * 64 + 8 * hi;
#pragma unroll
          for (int d0 = 0; d0 < 4; ++d0) qf[d0] = *(const bf16x8*)(qp + 16 * d0); }
        bf16x8 qaug;
#pragma unroll
        for (int i = 0; i < 8; ++i) qaug[i] = (short)((hi == 0 && i < 3) ? 0x3F80 : 0);
        const bf16_t* kg = QKV + ((size_t)(16 + h) * MTOK + rowb + (size_t)srow) * 64 + 8 * sc16;
        const bf16_t* vg = QKV + ((size_t)(32 + h) * MTOK + rowb + (size_t)srow) * 64 + 8 * sc16;
        const bf16_t* ag = KA + ((size_t)bh * SEQ + (size_t)(tid & 63)) * 8;
        u32x4 kr, vr, ar = (u32x4){0u, 0u, 0u, 0u};
        {
            const u32x4 k0 = *(const u32x4*)(kg + (size_t)T0 * 64 * 64), k1 = *(const u32x4*)(kg + (size_t)(T0 + 1) * 64 * 64), v0 = *(const u32x4*)(vg + (size_t)T0 * 64 * 64);
            u32x4 a0 = ar, a1 = ar; if (tid < 64) { a0 = *(const u32x4*)(ag + (size_t)T0 * 64 * 8); a1 = *(const u32x4*)(ag + (size_t)(T0 + 1) * 64 * 8); }
            kr = *(const u32x4*)(kg + (size_t)(T0 + 2) * 64 * 64); vr = *(const u32x4*)(vg + (size_t)(T0 + 1) * 64 * 64); if (tid < 64) ar = *(const u32x4*)(ag + (size_t)(T0 + 2) * 64 * 8);
            const int s0 = T0 & 1, s1 = s0 ^ 1;
            *(LAS u32x4*)(Kl + s0 * KB_BYTES + srow * KP + sc16 * 16) = k0; *(LAS u32x4*)(Kl + s1 * KB_BYTES + srow * KP + sc16 * 16) = k1; *(LAS u32x4*)(Vl + s0 * VB_BYTES + srow * VP + sc16 * 16) = v0;
            if (tid < 64) { *(LAS u32x4*)(Kl + s0 * KB_BYTES + tid * KP + 128) = a0; *(LAS u32x4*)(Kl + s1 * KB_BYTES + tid * KP + 128) = a1; }
        }
        __syncthreads();
        float ref = 0.f, l = 0.f; f32x16 o0 = zero16, o1 = zero16;
        f32x16 sA0, sA1, sB0 = zero16, sB1 = zero16;
        { LAS const unsigned char* kb_ = Kl + (T0 & 1) * KB_BYTES + r32 * KP; QKG0(sA0, sA1); QKG(1, sA0, sA1); QKG(2, sA0, sA1); QKG(3, sA0, sA1); QKA(sA0, sA1); }
        asm volatile("s_waitcnt lgkmcnt(0)\n\ts_barrier" ::: "memory");
        FOX_DECIDE(sA0, sA1, T0);
        int t = T0;
        for (; t + 1 <= NT - 6; t += 2) { FOX_IT(sA0, sA1, sB0, sB1, t); FOX_IT(sB0, sB1, sA0, sA1, t + 1); }
        if (t <= NT - 6) { FOX_IT(sA0, sA1, sB0, sB1, t); sA0 = sB0; sA1 = sB1; ++t; }
        for (; t < NT; ++t) {
            const bool v0_ = 64 * t <= wmax, v1_ = (t + 1 < NT) && (64 * (t + 1) <= wmax);
            if (v1_) { LAS const unsigned char* kb_ = Kl + ((t + 1) & 1) * KB_BYTES + r32 * KP; QKG0(sB0, sB1); QKG(1, sB0, sB1); QKG(2, sB0, sB1); QKG(3, sB0, sB1); QKA(sB0, sB1); }
            SB_();
            if (v0_) { float rs_ = 0.f; EXPR(sA0, 0, 16); EXPR(sA1, 0, 16); l += rs_;
                LAS const unsigned char* vb_ = Vl + (t & 1) * VB_BYTES + vlane; PVG(0, sA0, 0); PVG(1, sA0, 8); PVG(2, sA1, 0); PVG(3, sA1, 8); }
            SB_();
            if (v1_) { FOX_DECIDE(sB0, sB1, t + 1); sA0 = sB0; sA1 = sB1; }
            FOX_STAGE(t);
        }
        l = xadd32(l);
        const float inv = 1.0f / l;
        bf16_t* yp = Y + (rowb + (size_t)qtok) * DM + 64 * h + 4 * hi;
#pragma unroll
        for (int rg = 0; rg < 4; ++rg) { store_o4(yp + 8 * rg, o0[4 * rg] * inv, o0[4 * rg + 1] * inv, o0[4 * rg + 2] * inv, o0[4 * rg + 3] * inv);
            store_o4(yp + 32 + 8 * rg, o1[4 * rg] * inv, o1[4 * rg + 1] * inv, o1[4 * rg + 2] * inv, o1[4 * rg + 3] * inv); }
    }
#undef SB_
#undef QKG0
#undef QKG
#undef QKA
#undef EXPR
#undef MAXR
#undef PVG
#undef FOX_MASK
#undef FOX_REREF
#undef FOX_DECIDE
#undef FOX_STAGE
#undef FOX_IT
#undef KLD
#undef KLDA
#undef VLD
#undef PVM
}

typedef unsigned gu32_plain;
#define XB_TMO      128
#define XB_XCNT(j)  (256  + 64 * (j))
#define XB_XSUB(j)  (1280 + 64 * (j))
#define XB_XGEN(j)  (2304 + 64 * (j))
#define XB_TOP      3328
#define XB_TOPGEN   3392
#define XCD_BAR_WORDS 3456
#define XB_SPIN_CAP (1u << 18)

__device__ __forceinline__ unsigned xb_ld(unsigned* p)              { return __hip_atomic_load(p, __ATOMIC_RELAXED, __HIP_MEMORY_SCOPE_AGENT); }
__device__ __forceinline__ unsigned xb_add(unsigned* p, unsigned v) { return __hip_atomic_fetch_add(p, v, __ATOMIC_RELAXED, __HIP_MEMORY_SCOPE_AGENT); }
__device__ __forceinline__ unsigned xb_xcc_id() { return (unsigned)__builtin_amdgcn_s_getreg((3 << 11) | 20) & 0xFu; }
#define XB_SPIN(cond, bar) do { unsigned _sp = 0; while (cond) { __builtin_amdgcn_s_sleep(1); \
    if ((++_sp & 255u) == 0u) { if (xb_ld(&(bar)[XB_TMO])) break; if (_sp > XB_SPIN_CAP) { atomicAdd(&(bar)[XB_TMO], 1u); break; } } } } while (0)

struct XcdBarrier {
    unsigned* bar; unsigned x;
    volatile LAS unsigned* st;
};

__device__ __forceinline__ XcdBarrier xcd_barrier_post(unsigned* bar, volatile LAS unsigned* st) {
    XcdBarrier b; b.bar = bar; b.x = xb_xcc_id(); b.st = st;
    if (threadIdx.x == 0) (void)xb_add(&bar[XB_XCNT(b.x)], 1u);
    return b;
}
__device__ __forceinline__ void xcd_barrier_complete(unsigned* bar, unsigned x, unsigned& nloc, unsigned& nx) {
    const unsigned G = gridDim.x * gridDim.y * gridDim.z;
    unsigned sum, cnt, mine, sp = 0u;
    for (;;) {
        sum = 0u; cnt = 0u; mine = 0u;
#pragma unroll
        for (unsigned j = 0; j < 16; ++j) { const unsigned c = xb_ld(&bar[XB_XCNT(j)]); sum += c; cnt += (c > 0u) ? 1u : 0u; mine = (j == x) ? c : mine; }
        if (sum == G) break;
        __builtin_amdgcn_s_sleep(1);
        if ((++sp & 255u) == 0u) { if (xb_ld(&bar[XB_TMO])) break; if (sp > XB_SPIN_CAP) { atomicAdd(&bar[XB_TMO], 1u); break; } }
    }
    nloc = mine > 0u ? mine : 1u; nx = cnt > 0u ? cnt : 1u;
}

__device__ __forceinline__ void xcd_barrier(const XcdBarrier& b) {
    asm volatile("s_waitcnt vmcnt(0)" ::: "memory");
    __syncthreads();
    if (threadIdx.x == 0) {
        unsigned* bar = b.bar;
        __builtin_amdgcn_s_waitcnt(0);
        unsigned nloc = b.st[0], nx = b.st[1];
        if (nloc == 0u) { xcd_barrier_complete(bar, b.x, nloc, nx); b.st[0] = nloc; b.st[1] = nx; }
        const unsigned old = xb_add(&bar[XB_XSUB(b.x)], 1u);
        const unsigned gen = old / nloc;
        if (old + 1u == (gen + 1u) * nloc) {
            __builtin_amdgcn_fence(__ATOMIC_RELEASE, "agent");
            asm volatile("s_waitcnt vmcnt(0)" ::: "memory");
            const unsigned og = xb_add(&bar[XB_TOP], 1u);
            const unsigned tg = og / nx;
            if (og + 1u == (tg + 1u) * nx) xb_add(&bar[XB_TOPGEN], 1u);
            else XB_SPIN(xb_ld(&bar[XB_TOPGEN]) == tg, bar);
            __builtin_amdgcn_fence(__ATOMIC_ACQUIRE, "agent");
            xb_add(&bar[XB_XGEN(b.x)], 1u);
            asm volatile("s_waitcnt vmcnt(0)" ::: "memory");
        } else {
            XB_SPIN(xb_ld(&bar[XB_XGEN(b.x)]) == gen, bar);
            __builtin_amdgcn_fence(__ATOMIC_ACQUIRE, "agent");
            asm volatile("s_waitcnt vmcnt(0)" ::: "memory");
        }
    }
    __syncthreads();
}

template <class Epi> __device__ __forceinline__ void run_gemm(LAS unsigned char* lds, const bf16_t* A, const bf16_t* Bt, int N, int K, const Epi& E) {
    pg8::Gemm g{A, Bt, MTOK, N, K}; pg8::StaticOrder S; S.init(MTOK, N, (int)gridDim.x, (int)blockIdx.x);
    pg8::gemm_phase<Epi, pg8::StaticOrder, true, true>(lds, g, S, E);
}

__global__ void __launch_bounds__(512, 2) mega_fwd(Params p) {
    extern __shared__ __attribute__((aligned(16))) unsigned char lds_raw[];
    LAS unsigned char* lds = (LAS unsigned char*)lds_raw;
    cg::grid_group grid = cg::this_grid();
    const int tid = threadIdx.x, lane = tid & 63, wave = __builtin_amdgcn_readfirstlane(tid >> 6);
    unsigned char* ws = p.ws;
    bf16_t* XB = (bf16_t*)(ws + WS_XB); bf16_t* R = (bf16_t*)(ws + WS_R); bf16_t* Y = (bf16_t*)(ws + WS_Y);
    float* ssq = (float*)(ws + WS_SSQ); float* logf = (float*)(ws + WS_LOGF);
    const int lo = p.lo, hi = p.hi;
    __shared__ unsigned xb_state[2];
    if (tid < 2) xb_state[tid] = 0u;
    __syncthreads();
    XcdBarrier xbar = xcd_barrier_post((unsigned*)(ws + WS_CTL + 4096), (volatile LAS unsigned*)xb_state);
#define IN(k) (lo <= (k) && (k) < hi)
#ifndef PROBE_SYNC2
#define PROBE_SYNC2 0
#endif
#define SEAM(k) do { if ((k) + 1 < hi) { if ((k) == 0) grid.sync(); else xcd_barrier(xbar); if (PROBE_SYNC2) { xcd_barrier(xbar); xcd_barrier(xbar); } } } while (0)
#ifndef PROBE_REP
#define PROBE_REP -1
#endif
#define PH(k, ...) if (IN(k)) { for (int rr_ = 0; rr_ < ((PROBE_REP == (k)) ? 2 : 1); ++rr_) { if (rr_) grid.sync(); __VA_ARGS__; } SEAM(k); }
    PH(0, phase_prologue(p, lds, wave, lane))
    PH(1, { EpiIn<0> E{R, ssq, p.in[4], p.in[5], p.in[6], p.in[7], nullptr, nullptr}; run_gemm(lds, XB, (const bf16_t*)(ws + WS_WINE), N_INE, DM, E); })
#ifndef PROBE_WIN1
#define PROBE_WIN1 0
#endif
    PH(2, { phase_win2<0>(p, lds, tid, wave, lane); xcd_barrier(xbar); phase_win2<1>(p, lds, tid, wave, lane); if (PROBE_WIN1) { grid.sync(); phase_win2<1, PROBE_WIN1>(p, lds, tid, wave, lane); grid.sync(); phase_win2<1, PROBE_WIN1>(p, lds, tid, wave, lane); } })
    PH(3, { EpiRes<true, false> E{p.in[0], p.out, XB, ssq}; run_gemm(lds, Y, (const bf16_t*)(ws + WS_WOUTE), DM, DM, E); })
    PH(4, { EpiUp E{R, ssq}; run_gemm(lds, XB, (const bf16_t*)(ws + WS_WUP), DFF, DM, E); })
    PH(5, { EpiRes<false, false> E{nullptr, p.out, XB, ssq}; run_gemm(lds, R, (const bf16_t*)(ws + WS_WDN), DM, DFF, E); })
    PH(6, { EpiIn<1> E{R, ssq, p.in[12], p.in[13], nullptr, nullptr, logf, p.in[11]}; run_gemm(lds, XB, (const bf16_t*)(ws + WS_WINO), N_INO_PAD, DM, E); })
    PH(7, phase_cumsum(p, lds, tid, wave, lane))
    PH(8, { if (wave >= 4) __builtin_amdgcn_s_setprio(1); phase_fox(p, lds, tid, wave, lane, rr_); __builtin_amdgcn_s_setprio(0); })
    PH(9, { EpiRes<false, false> E{nullptr, p.out, XB, ssq}; run_gemm(lds, Y, (const bf16_t*)(ws + WS_WOUTO), DM, DM, E); })
    PH(10, { EpiUp E{R, ssq}; run_gemm(lds, XB, (const bf16_t*)(ws + WS_WUP) + (size_t)DM * DFF, DFF, DM, E); })
    PH(11, { EpiRes<false, true> E{nullptr, p.out, XB, ssq}; run_gemm(lds, R, (const bf16_t*)(ws + WS_WDN) + (size_t)DM * DFF, DM, DFF, E); })
#undef PH
#undef IN
#undef SEAM
}

#ifndef MK_MULTI
#define MK_MULTI 0
#endif
extern "C" void kernel_launch(void* const* d_in, const int* in_sizes, int n_in, void* d_out, int out_size, void* d_ws, size_t ws_size, hipStream_t stream) {
    static int grid = 0;
    if (grid == 0) {
        if (n_in != 17 || out_size != MTOK * DM || ws_size < WS_END2) { fprintf(stderr, "kernel_launch: unexpected shapes (n_in %d out %d ws %zu)\n", n_in, out_size, ws_size); grid = -1; return; }
        int dev = 0, cus = 0, per_cu = 0;
        hipGetDevice(&dev); hipDeviceGetAttribute(&cus, hipDeviceAttributeMultiprocessorCount, dev);
        if (hipFuncSetAttribute((const void*)mega_fwd, hipFuncAttributeMaxDynamicSharedMemorySize, LDS_BYTES) != hipSuccess) { fprintf(stderr, "kernel_launch: hipFuncSetAttribute failed\n"); grid = -1; return; }
        if (hipOccupancyMaxActiveBlocksPerMultiprocessor(&per_cu, (const void*)mega_fwd, 512, LDS_BYTES) != hipSuccess || per_cu < 1) { fprintf(stderr, "kernel_launch: occupancy query gave %d\n", per_cu); per_cu = 1; }
        (void)hipGetLastError();
        grid = cus * per_cu; if (grid > 256) grid = 256;
    }
    if (grid < 0) return;
    Params p{};
    for (int i = 0; i < 17; ++i) p.in[i] = (const float*)d_in[i];
    p.out = (float*)d_out; p.ws = (unsigned char*)d_ws;
    if (hipMemsetAsync((unsigned char*)d_ws + WS_CTL, 0, 32768, stream) != hipSuccess) { fprintf(stderr, "kernel_launch: memset failed\n"); return; }
#if MK_MULTI
    for (int k = 0; k < 12; ++k) { p.lo = k; p.hi = k + 1; hipLaunchKernelGGL(mega_fwd, dim3(grid), dim3(512), LDS_BYTES, stream, p); }
#else
    p.lo = 0; p.hi = 12;
    void* args[] = {&p};
    hipError_t e = hipLaunchCooperativeKernel((const void*)mega_fwd, dim3(grid), dim3(512), args, LDS_BYTES, stream);
    if (e != hipSuccess) fprintf(stderr, "kernel_launch: cooperative launch failed: %s (grid %d)\n", hipGetErrorString(e), grid);
#endif
}
```

```cpp
#include <hip/hip_runtime.h>
#include <hip/hip_cooperative_groups.h>
#include <cstdio>
#include <cstdint>
#include <cmath>
namespace cg = cooperative_groups;
namespace pg8 {
#define PG8_LAS __attribute__((address_space(3)))
typedef unsigned short bf16_t;
typedef short bf16x8 __attribute__((ext_vector_type(8)));
typedef float f32x4 __attribute__((ext_vector_type(4)));
typedef unsigned u32x4 __attribute__((ext_vector_type(4)));
constexpr int BM = 256, BK = 64, HALF = 128, HTB = HALF * BK * 2  , STAGE_BYTES = 8 * HTB, NXCD = 8, WGM = 8;

__host__ __device__ __forceinline__ int lds_byte(int r, int c) { const int st = (r >> 4) * 2 + (c >> 5), rr = r & 15, cc = c & 31, ob = rr * 64 + cc * 2; return st * 1024 + (ob ^ (((ob >> 9) & 1) << 5)); }
__host__ __device__ __forceinline__ void stage_rc(int b, int& R, int& C) { const int st = b / 1024, sb = b % 1024, swz = sb ^ (((sb >> 9) & 1) << 5); R = (st >> 1) * 16 + swz / 64; C = (st & 1) * 32 + (swz % 64) / 2; }
__host__ __device__ __forceinline__ int perm32(int rho) { const int n = rho >> 4, i = rho & 15; return 8 * (i >> 2) + 4 * n + (i & 3); }

struct Unit { int pm, pn; };
struct Gemm { const bf16_t* A; const bf16_t* Bt; int M, N, K; };

struct StaticOrder {
    int nM, nN, nwg, G, c;
    __host__ __device__ void init(int M, int N, int G_, int c_) { nM = M / BM; nN = N / BM; nwg = nM * nN; G = G_; c = c_; }
    __host__ __device__ bool next(int i, Unit& u) const {
        const long L = (long)i * G + c; if (L >= nwg) return false;
        int wgid = (int)L; { const int q = nwg / NXCD, r = nwg % NXCD, xcd = wgid % NXCD, off = wgid / NXCD; wgid = (xcd < r ? xcd * (q + 1) : r * (q + 1) + (xcd - r) * q) + off; }
        const int nig = WGM * nN, gid = wgid / nig, fm = gid * WGM, gsz = (nM - fm) < WGM ? (nM - fm) : WGM;
        u.pm = fm + ((wgid % nig) % gsz); u.pn = (wgid % nig) / gsz; return true;
    }
    __device__ __forceinline__ void a_ready(const Unit&) const {}
    __device__ __forceinline__ void done(const Unit&) const {}
};

__device__ __forceinline__ unsigned cvt_pk_bf16(float lo, float hi) { unsigned r; asm volatile("v_cvt_pk_bf16_f32 %0, %1, %2" : "=v"(r) : "v"(lo), "v"(hi)); return r; }
typedef float f32x2 __attribute__((ext_vector_type(2)));
template <class Epi, class Sched, bool ALIGN_EPI = false, bool SP2 = false>
__device__ __forceinline__ void gemm_phase(PG8_LAS unsigned char* lds, const Gemm g, const Sched& S, const Epi& E) {
    int tid_ = threadIdx.x; asm volatile("" : "+v"(tid_));
    const int tid = tid_, wid = __builtin_amdgcn_readfirstlane(tid >> 6), lane = tid & 63, wr = wid >> 2, wc = wid & 3, fr = lane & 15, fq = lane >> 4;
    const int K = g.K, nt = K / BK;
    unsigned voffA[2], voffB[2];
#pragma unroll
    for (int i = 0; i < 2; ++i) { int R, C; stage_rc(tid * 16 + i * 8192, R, C); const int Rb = Epi::PERM ? ((R & ~31) + perm32(R & 31)) : R;
        voffA[i] = (unsigned)(R * K + C) * 2u; voffB[i] = (unsigned)(Rb * K + C) * 2u; }
    const size_t kstep = (size_t)(BK * 2);
    const size_t hstep = (size_t)HALF * K * 2;
    const size_t tstep = 2 * hstep;
    const unsigned ldsw = (unsigned)wid * 1024u;
    const int aoff = lds_byte(wr * 64 + fr, fq * 8), boff = lds_byte(wc * 32 + fr, fq * 8);
#define PG8_SA(b, h) (((b) * 2 + (h)) * HTB)
#define PG8_SB(b, h) ((4 + (b) * 2 + (h)) * HTB)
#define PG8_STAGE(bufoff, gbase, voff) do { _Pragma("unroll") for (int _i = 0; _i < 2; ++_i) \
        __builtin_amdgcn_global_load_lds((const unsigned*)((const char*)(gbase) + (voff)[_i]), (PG8_LAS unsigned*)(lds + (bufoff) + ldsw + _i * 8192), 16, 0, 0); } while (0)
#define PG8_LDA(dst, b, h) do { _Pragma("unroll") for (int m = 0; m < 4; ++m) _Pragma("unroll") for (int k = 0; k < 2; ++k) dst[m][k] = *(const PG8_LAS bf16x8*)(lds + PG8_SA(b, h) + aoff + m * 2048 + k * 1024); } while (0)
#define PG8_LDB(dst, b, h) do { _Pragma("unroll") for (int n = 0; n < 2; ++n) _Pragma("unroll") for (int k = 0; k < 2; ++k) dst[n][k] = *(const PG8_LAS bf16x8*)(lds + PG8_SB(b, h) + boff + n * 2048 + k * 1024); } while (0)
#define PG8_MMA(ai, bj, At, Bt) do { __builtin_amdgcn_s_setprio(1); _Pragma("unroll") for (int m = 0; m < 4; ++m) _Pragma("unroll") for (int n = 0; n < 2; ++n) _Pragma("unroll") for (int k = 0; k < 2; ++k) \
        acc[ai][bj][m][n] = __builtin_amdgcn_mfma_f32_16x16x32_bf16(Bt[n][k], At[m][k], acc[ai][bj][m][n], 0, 0, 0); __builtin_amdgcn_s_setprio(0); } while (0)
#define PG8_WAIT_V(n) asm volatile("s_waitcnt vmcnt(" #n ")" ::: "memory")
#define PG8_WAIT_L(n) asm volatile("s_waitcnt lgkmcnt(" #n ")" ::: "memory")
#define PG8_BAR __builtin_amdgcn_s_barrier()
#define PG8_SCHED __builtin_amdgcn_sched_barrier(0)
    Unit cur, nxt; int ui = 0;
    if (!S.next(0, cur)) return;
    f32x4 acc[2][2][4][2];
#pragma unroll
    for (int a = 0; a < 2; ++a)
#pragma unroll
        for (int b = 0; b < 2; ++b)
#pragma unroll
            for (int m = 0; m < 4; ++m)
#pragma unroll
                for (int n = 0; n < 2; ++n) acc[a][b][m][n] = (f32x4){0.f, 0.f, 0.f, 0.f};
    bf16x8 At[4][2], B0[2][2], B1[2][2];
    const char* cA = (const char*)g.A + (size_t)cur.pm * tstep; const char* cB = (const char*)g.Bt + (size_t)cur.pn * tstep;
    S.a_ready(cur);
    if constexpr (SP2) {
        PG8_STAGE(PG8_SB(0, 0), cB, voffB); PG8_STAGE(PG8_SB(0, 1), cB + hstep, voffB); PG8_STAGE(PG8_SA(0, 0), cA, voffA); PG8_STAGE(PG8_SA(0, 1), cA + hstep, voffA);
        if (wr == 1) PG8_BAR;
        PG8_WAIT_V(2); PG8_BAR;
        PG8_STAGE(PG8_SB(1, 0), cB + kstep, voffB); PG8_STAGE(PG8_SA(1, 0), cA + kstep, voffA); PG8_STAGE(PG8_SB(1, 1), cB + hstep + kstep, voffB);
        PG8_WAIT_V(6); PG8_BAR;
    } else {
        PG8_STAGE(PG8_SB(0, 0), cB, voffB); PG8_STAGE(PG8_SA(0, 0), cA, voffA); PG8_STAGE(PG8_SB(0, 1), cB + hstep, voffB); PG8_STAGE(PG8_SA(0, 1), cA + hstep, voffA);
        if (wr == 1) PG8_BAR;
        PG8_WAIT_V(4); PG8_BAR;
        PG8_STAGE(PG8_SB(1, 0), cB + kstep, voffB); PG8_STAGE(PG8_SA(1, 0), cA + kstep, voffA); PG8_STAGE(PG8_SB(1, 1), cB + hstep + kstep, voffB);
        PG8_WAIT_V(6); PG8_BAR;
    }
    for (;;) {
        const bool has_next = S.next(ui + 1, nxt);
        const char* nA = has_next ? (const char*)g.A + (size_t)nxt.pm * tstep : cA; const char* nB = has_next ? (const char*)g.Bt + (size_t)nxt.pn * tstep : cB;
        for (int t = 0; t < nt; t += 2) {
            const bool last = (t == nt - 2);
            const char* a1 = cA + (size_t)(t + 1) * kstep;
            const char* a2 = last ? nA : cA + (size_t)(t + 2) * kstep; const char* b2 = last ? nB : cB + (size_t)(t + 2) * kstep;
            const char* a3 = a2 + kstep; const char* b3 = b2 + kstep;
            if (last && has_next) S.a_ready(nxt);
            if constexpr (SP2) {
            PG8_LDB(B0, 0, 0); PG8_LDB(B1, 0, 1); PG8_SCHED; PG8_LDA(At, 0, 0); PG8_STAGE(PG8_SA(1, 1), a1 + hstep, voffA);
            PG8_WAIT_V(8); PG8_WAIT_L(0); PG8_BAR; PG8_MMA(0, 0, At, B0); PG8_MMA(0, 1, At, B1); PG8_BAR; PG8_SCHED;
            PG8_LDA(At, 0, 1); PG8_STAGE(PG8_SB(0, 0), b2, voffB); PG8_STAGE(PG8_SB(0, 1), b2 + hstep, voffB); PG8_STAGE(PG8_SA(0, 0), a2, voffA);
            PG8_WAIT_V(8); PG8_WAIT_L(0); PG8_BAR; PG8_MMA(1, 0, At, B0); PG8_MMA(1, 1, At, B1); PG8_BAR; PG8_SCHED;
            PG8_LDB(B0, 1, 0); PG8_LDB(B1, 1, 1); PG8_SCHED; PG8_LDA(At, 1, 0); PG8_STAGE(PG8_SA(0, 1), a2 + hstep, voffA);
            PG8_WAIT_V(8); PG8_WAIT_L(0); PG8_BAR; PG8_MMA(0, 0, At, B0); PG8_MMA(0, 1, At, B1); PG8_BAR; PG8_SCHED;
            PG8_LDA(At, 1, 1); PG8_STAGE(PG8_SB(1, 0), b3, voffB); PG8_STAGE(PG8_SB(1, 1), b3 + hstep, voffB); PG8_STAGE(PG8_SA(1, 0), a3, voffA);
            PG8_WAIT_V(8); PG8_WAIT_L(0); PG8_BAR; PG8_MMA(1, 0, At, B0); PG8_MMA(1, 1, At, B1); PG8_BAR; PG8_SCHED;
            } else {
            PG8_LDB(B0, 0, 0); PG8_SCHED; PG8_LDA(At, 0, 0); PG8_STAGE(PG8_SA(1, 1), a1 + hstep, voffA);
            PG8_WAIT_L(8); PG8_BAR; PG8_WAIT_L(0); PG8_MMA(0, 0, At, B0); PG8_BAR; PG8_SCHED;
            PG8_LDB(B1, 0, 1); PG8_STAGE(PG8_SB(0, 0), b2, voffB);
            PG8_BAR; PG8_WAIT_L(0); PG8_MMA(0, 1, At, B1); PG8_BAR;
            PG8_LDA(At, 0, 1); PG8_STAGE(PG8_SA(0, 0), a2, voffA);
            PG8_BAR; PG8_WAIT_L(0); PG8_MMA(1, 0, At, B0); PG8_BAR; PG8_SCHED;
            PG8_STAGE(PG8_SB(0, 1), b2 + hstep, voffB);
            PG8_WAIT_V(6); PG8_BAR; PG8_MMA(1, 1, At, B1); PG8_BAR;
            PG8_LDB(B0, 1, 0); PG8_SCHED; PG8_LDA(At, 1, 0); PG8_STAGE(PG8_SA(0, 1), a2 + hstep, voffA);
            PG8_WAIT_L(8); PG8_BAR; PG8_WAIT_L(0); PG8_MMA(0, 0, At, B0); PG8_BAR; PG8_SCHED;
            PG8_LDB(B1, 1, 1); PG8_STAGE(PG8_SB(1, 0), b3, voffB);
            PG8_BAR; PG8_WAIT_L(0); PG8_MMA(0, 1, At, B1); PG8_BAR;
            PG8_LDA(At, 1, 1); PG8_STAGE(PG8_SA(1, 0), a3, voffA);
            PG8_BAR; PG8_WAIT_L(0); PG8_MMA(1, 0, At, B0); PG8_BAR; PG8_SCHED;
            PG8_STAGE(PG8_SB(1, 1), b3 + hstep, voffB);
            PG8_WAIT_V(6); PG8_BAR; PG8_MMA(1, 1, At, B1); PG8_BAR;
            }
        }
        if constexpr (ALIGN_EPI) { if (wr == 0) PG8_BAR; }
        if constexpr (!Epi::AFTER_DRAIN) { E(acc, cur, wr, wc, fr, fq); S.done(cur); }
        if (!has_next) break;
#pragma unroll
        for (int a = 0; a < 2; ++a)
#pragma unroll
            for (int b = 0; b < 2; ++b)
#pragma unroll
                for (int m = 0; m < 4; ++m)
#pragma unroll
                    for (int n = 0; n < 2; ++n) acc[a][b][m][n] = (f32x4){0.f, 0.f, 0.f, 0.f};
        cur = nxt; cA = nA; cB = nB; ++ui;
        if constexpr (ALIGN_EPI) { if (wr == 1) PG8_BAR; }
    }
    PG8_WAIT_V(0);
    if constexpr (!ALIGN_EPI) { if (wr == 0) PG8_BAR; }
    PG8_BAR;
    if constexpr (Epi::AFTER_DRAIN) { E.fused(acc, cur, wr, wc, fr, fq, lds, wid, lane); S.done(cur); }
#undef PG8_SA
#undef PG8_SB
#undef PG8_STAGE
#undef PG8_LDA
#undef PG8_LDB
#undef PG8_MMA
#undef PG8_WAIT_V
#undef PG8_WAIT_L
#undef PG8_BAR
#undef PG8_SCHED
}
}

#define LAS __attribute__((address_space(3)))
typedef pg8::bf16_t bf16_t;
typedef pg8::f32x4 f32x4;
typedef pg8::u32x4 u32x4;
typedef pg8::bf16x8 bf16x8;
typedef float f32x16 __attribute__((ext_vector_type(16)));
typedef short s16x4 __attribute__((ext_vector_type(4)));
typedef unsigned u32x2 __attribute__((ext_vector_type(2)));
using pg8::cvt_pk_bf16;

constexpr int BATCH = 8, SEQ = 8192, DM = 1024, MTOK = BATCH * SEQ, DFF = 4096;
constexpr int N_INE = 2304, N_INO = 3088, N_INO_PAD = 3328, LD_E = 2304, LD_O = 3072;
constexpr float EPS = 1e-6f, LOG2E = 1.4426950408889634f, QSCALE = 0.125f * 1.4426950408889634f;
constexpr size_t MiB = (size_t)1 << 20;
constexpr size_t WS_WINE = 0, WS_WOUTE = 5 * MiB, WS_WINO = 7 * MiB, WS_WOUTO = 14 * MiB, WS_WUP = 16 * MiB, WS_WDN = 32 * MiB;
constexpr size_t WS_SSQ = 48 * MiB, WS_LOGF = 52 * MiB, WS_KAUG = 56 * MiB, WS_SCR = 72 * MiB, WS_XB = 144 * MiB, WS_R = 272 * MiB, WS_Y = WS_R + 384 * MiB, WS_CTL = 784 * MiB, WS_END = 785 * MiB;
constexpr int SCR_FLOATS = 2 * 512 * 64 + 2 * 512 * 2;
constexpr int LDS_BYTES = 131072;
constexpr int NPHASE = 13;

struct Params { const float* in[17]; float* out; unsigned char* ws; int lo, hi; };

__device__ __forceinline__ unsigned f2bf(float f) { unsigned u = __builtin_bit_cast(unsigned, f); return (u + 0x7fffu + ((u >> 16) & 1u)) >> 16; }
__device__ __forceinline__ float bf2f(unsigned b) { return __builtin_bit_cast(float, b << 16); }
__device__ __forceinline__ float wave_sum(float v) {
#pragma unroll
    for (int o = 1; o < 64; o <<= 1) v += __shfl_xor(v, o);
    return v;
}
#define LDS_WAIT() asm volatile("s_waitcnt lgkmcnt(0)" ::: "memory")
__device__ __forceinline__ float xadd16(float v) { auto rr = __builtin_amdgcn_permlane16_swap(__float_as_uint(v), __float_as_uint(v), false, false); return __uint_as_float(rr[0]) + __uint_as_float(rr[1]); }
__device__ __forceinline__ float xadd32(float v) { auto rr = __builtin_amdgcn_permlane32_swap(__float_as_uint(v), __float_as_uint(v), false, false); return __uint_as_float(rr[0]) + __uint_as_float(rr[1]); }
__device__ __forceinline__ float xmax32(float v) { auto rr = __builtin_amdgcn_permlane32_swap(__float_as_uint(v), __float_as_uint(v), false, false); return fmaxf(__uint_as_float(rr[0]), __uint_as_float(rr[1])); }

__device__ __forceinline__ void rows_rstd(const float* ssq, int row0, int fq, float (&rs)[2][4]) {
    f32x4 t[2][4];
#pragma unroll
    for (int ai = 0; ai < 2; ++ai)
#pragma unroll
        for (int m = 0; m < 4; ++m) t[ai][m] = *(const f32x4*)(ssq + (size_t)(row0 + ai * 128 + m * 16) * 16 + 4 * fq);
#pragma unroll
    for (int ai = 0; ai < 2; ++ai)
#pragma unroll
        for (int m = 0; m < 4; ++m) { float q = (t[ai][m][0] + t[ai][m][1]) + (t[ai][m][2] + t[ai][m][3]); q = xadd32(xadd16(q)); rs[ai][m] = 1.0f / sqrtf(q * (1.0f / 1024.0f) + EPS); }
}
__device__ __forceinline__ float log_sigmoid(float x) { return x >= 0.f ? -log1pf(expf(-x)) : x - log1pf(expf(x)); }

template <int ODD> struct EpiIn {
    static constexpr bool PERM = true, AFTER_DRAIN = false;
    bf16_t* O; const float* ssq; const float* g0; const float* g1; const float* g2; const float* g3; float* logf; const float* bfg;
    __device__ __forceinline__ void operator()(const f32x4 (&acc)[2][2][4][2], const pg8::Unit& u, int wr, int wc, int fr, int fq) const {
        const int hg = u.pn * 4 + wc;
        int cls = 0; const float* gp = nullptr;
        if (ODD) { if (hg < 16) { cls = 1; gp = g0; } else if (hg < 32) { cls = 2; gp = g1; } else if (hg < 48) cls = 0; else cls = 3; }
        else { if (hg < 8) { cls = 1; gp = g0; } else if (hg < 16) { cls = 2; gp = g1; } else if (hg < 24) cls = 0; else if (hg < 32) { cls = 1; gp = g2; } else if (hg < 34) { cls = 2; gp = g3; } else cls = 0; }
        f32x4 gv[2][2];
#pragma unroll
        for (int bj = 0; bj < 2; ++bj)
#pragma unroll
            for (int n = 0; n < 2; ++n) gv[bj][n] = gp ? *(const f32x4*)(gp + 32 * bj + 8 * fq + 4 * n) : (f32x4){1.f, 1.f, 1.f, 1.f};
        const float qs = (cls == 1) ? QSCALE : 1.f;
        float rs[2][4]; rows_rstd(ssq, u.pm * 256 + wr * 64 + fr, fq, rs);
#pragma unroll
        for (int ai = 0; ai < 2; ++ai)
#pragma unroll
            for (int m = 0; m < 4; ++m) {
                const int row = u.pm * 256 + ai * 128 + wr * 64 + m * 16 + fr;
                const float rstd = rs[ai][m];
                f32x4 v[2][2];
#pragma unroll
                for (int bj = 0; bj < 2; ++bj)
#pragma unroll
                    for (int n = 0; n < 2; ++n) v[bj][n] = acc[ai][bj][m][n] * rstd;
                if (ODD && cls == 3) {
                    if (wc == 0 && fq < 2) {
#pragma unroll
                        for (int n = 0; n < 2; ++n)
#pragma unroll
                            for (int i = 0; i < 4; ++i) { const int hf = 8 * fq + 4 * n + i; logf[(size_t)row * 16 + hf] = log_sigmoid(v[0][n][i] + bfg[hf]); }
                    }
                    continue;
                }
                if (cls == 1 || cls == 2) {
                    float q = 0.f;
#pragma unroll
                    for (int bj = 0; bj < 2; ++bj)
#pragma unroll
                        for (int n = 0; n < 2; ++n) { const f32x4 x = v[bj][n]; q += (x[0] * x[0] + x[1] * x[1]) + (x[2] * x[2] + x[3] * x[3]); }
                    q = xadd32(xadd16(q));
                    const float r = qs / sqrtf(q * (1.0f / 64.0f) + EPS);
#pragma unroll
                    for (int bj = 0; bj < 2; ++bj)
#pragma unroll
                        for (int n = 0; n < 2; ++n) v[bj][n] = v[bj][n] * r * gv[bj][n];
                }
                bf16_t* rowp = O + ((size_t)hg * MTOK + (size_t)row) * 64 + 8 * fq;
#pragma unroll
                for (int bj = 0; bj < 2; ++bj) { u32x4 w; w.x = cvt_pk_bf16(v[bj][0][0], v[bj][0][1]); w.y = cvt_pk_bf16(v[bj][0][2], v[bj][0][3]); w.z = cvt_pk_bf16(v[bj][1][0], v[bj][1][1]); w.w = cvt_pk_bf16(v[bj][1][2], v[bj][1][3]);
                    *(u32x4*)(rowp + 32 * bj) = w; }
            }
    }
};
template <bool RES_F32, bool LAST> struct EpiRes {
    static constexpr bool PERM = true, AFTER_DRAIN = false;
    const float* res; float* out; bf16_t* xb; float* ssq;
    __device__ __forceinline__ void operator()(const f32x4 (&acc)[2][2][4][2], const pg8::Unit& u, int wr, int wc, int fr, int fq) const {
        const int col0 = u.pn * 256 + wc * 32 + 8 * fq;
#pragma unroll
        for (int ai = 0; ai < 2; ++ai) {
            f32x4 rr[4][2][2];
#pragma unroll
            for (int m = 0; m < 4; ++m)
#pragma unroll
                for (int bj = 0; bj < 2; ++bj) { const size_t off = (size_t)(u.pm * 256 + ai * 128 + wr * 64 + m * 16 + fr) * DM + col0 + bj * 128;
                    if (RES_F32) { rr[m][bj][0] = *(const f32x4*)(res + off); rr[m][bj][1] = *(const f32x4*)(res + off + 4); }
                    else { const u32x4 w = *(const u32x4*)(xb + off);
                        rr[m][bj][0] = (f32x4){bf2f(w.x & 0xffffu), bf2f(w.x >> 16), bf2f(w.y & 0xffffu), bf2f(w.y >> 16)}; rr[m][bj][1] = (f32x4){bf2f(w.z & 0xffffu), bf2f(w.z >> 16), bf2f(w.w & 0xffffu), bf2f(w.w >> 16)}; } }
            asm volatile("" ::: "memory");
#pragma unroll
            for (int m = 0; m < 4; ++m) {
                const int row = u.pm * 256 + ai * 128 + wr * 64 + m * 16 + fr; float q = 0.f;
#pragma unroll
                for (int bj = 0; bj < 2; ++bj) { const size_t off = (size_t)row * DM + col0 + bj * 128;
                    const f32x4 v0 = acc[ai][bj][m][0] + rr[m][bj][0], v1 = acc[ai][bj][m][1] + rr[m][bj][1];
                    if (LAST) { *(f32x4*)(out + off) = v0; *(f32x4*)(out + off + 4) = v1; }
                    else {
                        q += (v0[0] * v0[0] + v0[1] * v0[1]) + (v0[2] * v0[2] + v0[3] * v0[3]) + (v1[0] * v1[0] + v1[1] * v1[1]) + (v1[2] * v1[2] + v1[3] * v1[3]);
                        u32x4 w; w.x = cvt_pk_bf16(v0[0], v0[1]); w.y = cvt_pk_bf16(v0[2], v0[3]); w.z = cvt_pk_bf16(v1[0], v1[1]); w.w = cvt_pk_bf16(v1[2], v1[3]);
                        *(u32x4*)(xb + off) = w; } }
                if (!LAST) { q = xadd32(xadd16(q)); if (fq == 0) ssq[(size_t)row * 16 + u.pn * 4 + wc] = q; }
            }
        }
    }
};
struct EpiUp {
    static constexpr bool PERM = true, AFTER_DRAIN = false;
    bf16_t* H; const float* ssq;
    __device__ __forceinline__ void operator()(const f32x4 (&acc)[2][2][4][2], const pg8::Unit& u, int wr, int wc, int fr, int fq) const {
        const int col0 = u.pn * 256 + wc * 32 + 8 * fq;
        float rs[2][4]; rows_rstd(ssq, u.pm * 256 + wr * 64 + fr, fq, rs);
#pragma unroll
        for (int ai = 0; ai < 2; ++ai)
#pragma unroll
            for (int m = 0; m < 4; ++m) {
                const int row = u.pm * 256 + ai * 128 + wr * 64 + m * 16 + fr;
                const float rstd = rs[ai][m];
#pragma unroll
                for (int bj = 0; bj < 2; ++bj) {
                    f32x4 v0 = acc[ai][bj][m][0] * rstd, v1 = acc[ai][bj][m][1] * rstd;
#pragma unroll
                    for (int i = 0; i < 4; ++i) { const float a = fmaxf(v0[i], 0.f), b = fmaxf(v1[i], 0.f); v0[i] = a * a; v1[i] = b * b; }
                    u32x4 w; w.x = cvt_pk_bf16(v0[0], v0[1]); w.y = cvt_pk_bf16(v0[2], v0[3]); w.z = cvt_pk_bf16(v1[0], v1[1]); w.w = cvt_pk_bf16(v1[2], v1[3]);
                    __builtin_nontemporal_store(w, (u32x4*)(H + (size_t)row * DFF + col0 + bj * 128)); }
            }
    }
};

__device__ __forceinline__ void tr_item(const float* W, int K, int N, int Npad, bf16_t* WT, const float* gain, bool hp, LAS float* scr, int item, int lane) {
    const int nblk = Npad / 32, kb = item / nblk, nb = item % nblk, k0 = 64 * kb, n0 = 32 * nb;
    const int nn = n0 + (lane & 31); const bool okn = nn < N;
#pragma unroll 8
    for (int i = 0; i < 32; ++i) { const int kk = 2 * i + (lane >> 5); float v = okn ? W[(size_t)(k0 + kk) * N + nn] : 0.f; if (gain) v *= gain[k0 + kk]; scr[kk * 33 + (lane & 31)] = v; }
    LDS_WAIT();
    int r0 = n0; if (hp) { const int pn = n0 >> 8, w = (n0 >> 6) & 3, bj = (n0 >> 5) & 1; r0 = pn * 256 + bj * 128 + w * 32; }
    const int c = lane & 7;
#pragma unroll
    for (int j = 0; j < 4; ++j) { const int n = (lane >> 3) + 8 * j; const LAS float* s = scr + (8 * c) * 33 + n;
        u32x4 o; o.x = cvt_pk_bf16(s[0 * 33], s[1 * 33]); o.y = cvt_pk_bf16(s[2 * 33], s[3 * 33]); o.z = cvt_pk_bf16(s[4 * 33], s[5 * 33]); o.w = cvt_pk_bf16(s[6 * 33], s[7 * 33]);
        *(u32x4*)(WT + (size_t)(r0 + n) * K + k0 + 8 * c) = o; }
    LDS_WAIT();
}
__device__ __forceinline__ void phase_prologue(const Params& p, LAS unsigned char* lds, int wave, int lane) {
    LAS float* scr = (LAS float*)(lds + wave * 16384);
    const int gw = blockIdx.x * 8 + wave, NGW = gridDim.x * 8;
    constexpr int I_INE = 16 * (N_INE / 32), I_OUT = 16 * 32, I_INO = 16 * (N_INO_PAD / 32), I_UP = 16 * 128, I_DN = 64 * 32;
    constexpr int NIT = I_INE + 2 * I_OUT + I_INO + 2 * I_UP + 2 * I_DN;
    unsigned char* ws = p.ws;
    for (int it = gw; it < NIT; it += NGW) {
        int r = it;
        if (r < I_INE) { tr_item(p.in[3], DM, N_INE, N_INE, (bf16_t*)(ws + WS_WINE), p.in[1], true, scr, r, lane); continue; } r -= I_INE;
        if (r < I_OUT) { tr_item(p.in[9], DM, DM, DM, (bf16_t*)(ws + WS_WOUTE), nullptr, false, scr, r, lane); continue; } r -= I_OUT;
        if (r < I_INO) { tr_item(p.in[10], DM, N_INO, N_INO_PAD, (bf16_t*)(ws + WS_WINO), p.in[1] + DM, true, scr, r, lane); continue; } r -= I_INO;
        if (r < I_OUT) { tr_item(p.in[14], DM, DM, DM, (bf16_t*)(ws + WS_WOUTO), nullptr, false, scr, r, lane); continue; } r -= I_OUT;
        if (r < 2 * I_UP) { const int l = r / I_UP; r -= l * I_UP; tr_item(p.in[15] + (size_t)l * DM * DFF, DM, DFF, DFF, (bf16_t*)(ws + WS_WUP) + (size_t)l * DM * DFF, p.in[2] + l * DM, false, scr, r, lane); continue; } r -= 2 * I_UP;
        { const int l = r / I_DN; r -= l * I_DN; tr_item(p.in[16] + (size_t)l * DM * DFF, DFF, DM, DM, (bf16_t*)(ws + WS_WDN) + (size_t)l * DM * DFF, nullptr, false, scr, r, lane); }
    }
    const float* x = p.in[0]; bf16_t* xb = (bf16_t*)(ws + WS_XB); float* ssq = (float*)(ws + WS_SSQ);
    for (int m = gw; m < MTOK; m += NGW) {
        const f32x4* xr = (const f32x4*)(x + (size_t)m * DM) + lane; f32x4 v[4]; float s = 0.f;
#pragma unroll
        for (int j = 0; j < 4; ++j) { v[j] = xr[64 * j]; s += (v[j].x * v[j].x + v[j].y * v[j].y) + (v[j].z * v[j].z + v[j].w * v[j].w); }
        s = wave_sum(s);
        u32x2* o8 = (u32x2*)(xb + (size_t)m * DM) + lane;
#pragma unroll
        for (int j = 0; j < 4; ++j) { u32x2 w; w.x = cvt_pk_bf16(v[j].x, v[j].y); w.y = cvt_pk_bf16(v[j].z, v[j].w); o8[64 * j] = w; }
        if (lane < 16) ssq[(size_t)m * 16 + lane] = (lane == 0) ? s : 0.f;
    }
}

typedef short v4i16_t __attribute__((ext_vector_type(4)));
__device__ __forceinline__ s16x4 tr_read(LAS const unsigned char* p) { return __builtin_bit_cast(s16x4, __builtin_amdgcn_ds_read_tr16_b64_v4i16((LAS v4i16_t*)p)); }
constexpr int VP = 192;
__device__ __forceinline__ bf16x8 vt_frag(LAS const unsigned char* p) {
    const s16x4 lo = tr_read(p), hi = tr_read(p + 8 * VP);
    return (bf16x8){lo[0], lo[1], lo[2], lo[3], hi[0], hi[1], hi[2], hi[3]};
}
__device__ __forceinline__ bf16x8 pack8(const f32x16& p, int b) {
    u32x4 w; w.x = cvt_pk_bf16(p[b + 0], p[b + 1]); w.y = cvt_pk_bf16(p[b + 2], p[b + 3]); w.z = cvt_pk_bf16(p[b + 4], p[b + 5]); w.w = cvt_pk_bf16(p[b + 6], p[b + 7]);
    return __builtin_bit_cast(bf16x8, w);
}
__device__ __forceinline__ float max3f(float a, float b, float c) { float r; asm("v_max3_f32 %0, %1, %2, %3" : "=v"(r) : "v"(a), "v"(b), "v"(c)); return r; }
#define MFMA32(a, b, c) __builtin_amdgcn_mfma_f32_32x32x16_bf16((a), (b), (c), 0, 0, 0)

__device__ __forceinline__ void win_tile(const bf16_t* Q, const bf16_t* K, const bf16_t* V, size_t rowb, int t0, int stride, int W, float slope2, float m_init, float l_init,
                                         LAS unsigned char* vl, int lane, f32x16 (&o)[2], float& m_out, float& l_out) {
    const int r32 = lane & 31, hi = lane >> 5;
    const bf16_t* qp = Q + (rowb + (size_t)(t0 + r32 * stride)) * LD_E + 8 * hi;
    bf16x8 qf[4];
#pragma unroll
    for (int d0 = 0; d0 < 4; ++d0) qf[d0] = *(const bf16x8*)(qp + 16 * d0);
    const unsigned vlane = (unsigned)((4 * hi + ((lane >> 2) & 3)) * VP + (16 * ((lane >> 4) & 1) + 4 * (lane & 3)) * 2);
    LAS const unsigned char* vb = vl + vlane;
    float bt[16];
#pragma unroll
    for (int r = 0; r < 16; ++r) bt[r] = slope2 * (float)((r & 3) + 8 * (r >> 2) + 4 * hi);
    const float rowc = slope2 * (float)r32;
    float m = m_init + rowc, l = l_init;
#pragma unroll
    for (int r = 0; r < 16; ++r) { o[0][r] = 0.f; o[1][r] = 0.f; }
    bf16x8 kf[4]; u32x4 vr[4];
#define WT_LOAD(KT, KF, VR) do { const int rel0_ = ((KT) - 4) * 32; int tk_ = t0 + (rel0_ + r32) * stride; tk_ = tk_ < 0 ? 0 : tk_; const bf16_t* kp_ = K + (rowb + (size_t)tk_) * LD_E + 8 * hi; \
        _Pragma("unroll") for (int d0 = 0; d0 < 4; ++d0) KF[d0] = *(const bf16x8*)(kp_ + 16 * d0); \
        _Pragma("unroll") for (int i = 0; i < 4; ++i) { const int ci = lane + 64 * i, row = ci >> 3, c16 = ci & 7; int tv = t0 + (rel0_ + row) * stride; tv = tv < 0 ? 0 : tv; VR[i] = *(const u32x4*)(V + (rowb + (size_t)tv) * LD_E + 8 * c16); } } while (0)
    WT_LOAD(4, kf, vr);
#pragma unroll 1
    for (int kt = 4; kt >= 0; --kt) {
        const int rel0 = (kt - 4) * 32;
#pragma unroll
        for (int i = 0; i < 4; ++i) { const int ci = lane + 64 * i, row = ci >> 3, c16 = ci & 7; *(LAS u32x4*)(vl + row * VP + c16 * 16) = vr[i]; }
        asm volatile("" ::: "memory");
        bf16x8 kn[4]; u32x4 vn[4];
        { const int ktn = kt > 0 ? kt - 1 : 0; WT_LOAD(ktn, kn, vn); }
        f32x16 p;
#pragma unroll
        for (int r = 0; r < 16; ++r) p[r] = 0.f;
#pragma unroll
        for (int d0 = 0; d0 < 4; ++d0) p = MFMA32(kf[d0], qf[d0], p);
        const float cb = slope2 * (float)rel0;
        float mx = -INFINITY;
        if (kt == 4 || kt == 0 || (t0 + rel0 * stride < 0)) {
#pragma unroll
            for (int r = 0; r < 16; ++r) { const int kv = (r & 3) + 8 * (r >> 2) + 4 * hi; const int dist = r32 - rel0 - kv; const int tkk = t0 + (rel0 + kv) * stride;
                const bool ok = (dist >= 0) && (dist <= W) && (tkk >= 0);
                p[r] = ok ? p[r] + (bt[r] + cb) : -INFINITY; mx = fmaxf(mx, p[r]); }
        } else {
#pragma unroll
            for (int r = 0; r < 16; ++r) { p[r] = p[r] + (bt[r] + cb); mx = fmaxf(mx, p[r]); }
        }
        mx = xmax32(mx);
        const float mn = fmaxf(m, mx);
        if (__any(mn > m)) {
            const float alpha = __builtin_amdgcn_exp2f(m - mn); l *= alpha;
#pragma unroll
            for (int r = 0; r < 16; ++r) { o[0][r] *= alpha; o[1][r] *= alpha; }
        }
        m = mn;
        float rs = 0.f;
#pragma unroll
        for (int r = 0; r < 16; ++r) { p[r] = __builtin_amdgcn_exp2f(p[r] - mn); rs += p[r]; }
        l += rs;
        const bf16x8 pb0 = pack8(p, 0), pb1 = pack8(p, 8);
#pragma unroll
        for (int dblk = 0; dblk < 2; ++dblk) {
            const bf16x8 a0 = vt_frag(vb + dblk * 64), a1 = vt_frag(vb + 16 * VP + dblk * 64);
            o[dblk] = MFMA32(a0, pb0, o[dblk]); o[dblk] = MFMA32(a1, pb1, o[dblk]);
        }
        asm volatile("" ::: "memory");
#pragma unroll
        for (int d0 = 0; d0 < 4; ++d0) kf[d0] = kn[d0];
#pragma unroll
        for (int i = 0; i < 4; ++i) vr[i] = vn[i];
    }
#undef WT_LOAD
    m_out = m - rowc; l_out = l;
}
__device__ __forceinline__ void store_o4(bf16_t* dst, float a, float b, float c, float d) { u32x2 w; w.x = cvt_pk_bf16(a, b); w.y = cvt_pk_bf16(c, d); *(u32x2*)dst = w; }

__device__ __forceinline__ void phase_win(const Params& p, LAS unsigned char* lds, int wave, int lane) {
    const bf16_t* QKV = (const bf16_t*)(p.ws + WS_R); bf16_t* Y = (bf16_t*)(p.ws + WS_Y);
    float* scr = (float*)(p.ws + WS_SCR) + (size_t)blockIdx.x * SCR_FLOATS; float* scml = scr + 2 * 512 * 64;
    LAS unsigned char* vl = lds + wave * 6144;
    const int r32 = lane & 31, hi = lane >> 5;
    const int G = gridDim.x, vcu = (G % 8 == 0) ? ((int)blockIdx.x % 8) * (G / 8) + (int)blockIdx.x / 8 : (int)blockIdx.x;
    for (int u = vcu; u < 1024; u += G) {
        const int span = u & 15, head = (u >> 4) & 7, b = u >> 7, T0 = span * 512; const size_t rowb = (size_t)b * SEQ;
        const float slope = exp2f(-0.5f * (float)(9 + head));
        const bf16_t *Qh = QKV + 64 * head, *Kh = QKV + 512 + 64 * head, *Vh = QKV + 1024 + 64 * head;
        for (int tt = wave; tt < 32; tt += 8) {
            int br, stride, t0;
            if (tt < 16) { br = 0; stride = 16; t0 = T0 + tt; } else { const int t4 = tt - 16; br = 1; stride = 4; t0 = T0 + (t4 & 3) + 128 * (t4 >> 2); }
            f32x16 o[2]; float m, l;
            win_tile(Qh, Kh, Vh, rowb, t0, stride, 128, slope * (float)stride * LOG2E, -INFINITY, 0.f, vl, lane, o, m, l);
            l += __shfl_xor(l, 32);
            const int tis = (t0 - T0) + r32 * stride;
            float* op = scr + ((size_t)br * 512 + tis) * 64 + 4 * hi;
#pragma unroll
            for (int dblk = 0; dblk < 2; ++dblk)
#pragma unroll
                for (int rg = 0; rg < 4; ++rg) *(f32x4*)(op + 32 * dblk + 8 * rg) = (f32x4){o[dblk][4 * rg], o[dblk][4 * rg + 1], o[dblk][4 * rg + 2], o[dblk][4 * rg + 3]};
            if (hi == 0) { scml[(br * 512 + tis) * 2] = m; scml[(br * 512 + tis) * 2 + 1] = l; }
        }
        __syncthreads();
        for (int tt = wave; tt < 16; tt += 8) {
            const int t0 = T0 + 32 * tt;
            f32x16 o[2]; float m, l;
            win_tile(Qh, Kh, Vh, rowb, t0, 1, 128, slope * LOG2E, -INFINITY, 0.f, vl, lane, o, m, l);
            l += __shfl_xor(l, 32);
            const int tis = 32 * tt + r32;
            const float m16 = scml[tis * 2], l16 = scml[tis * 2 + 1], m4 = scml[(512 + tis) * 2], l4 = scml[(512 + tis) * 2 + 1];
            const float M = fmaxf(m, fmaxf(m16, m4));
            const float w1 = __builtin_amdgcn_exp2f(m - M), w16 = __builtin_amdgcn_exp2f(m16 - M), w4 = __builtin_amdgcn_exp2f(m4 - M);
            const float inv = 1.0f / (l * w1 + l16 * w16 + l4 * w4);
            const float* o16 = scr + (size_t)tis * 64 + 4 * hi; const float* o4 = scr + ((size_t)512 + tis) * 64 + 4 * hi;
            bf16_t* yp = Y + (rowb + (size_t)(t0 + r32)) * DM + 64 * head + 4 * hi;
#pragma unroll
            for (int dblk = 0; dblk < 2; ++dblk)
#pragma unroll
                for (int rg = 0; rg < 4; ++rg) { const f32x4 a = *(const f32x4*)(o16 + 32 * dblk + 8 * rg), c = *(const f32x4*)(o4 + 32 * dblk + 8 * rg);
                    store_o4(yp + 32 * dblk + 8 * rg, (o[dblk][4 * rg] * w1 + a[0] * w16 + c[0] * w4) * inv, (o[dblk][4 * rg + 1] * w1 + a[1] * w16 + c[1] * w4) * inv,
                             (o[dblk][4 * rg + 2] * w1 + a[2] * w16 + c[2] * w4) * inv, (o[dblk][4 * rg + 3] * w1 + a[3] * w16 + c[3] * w4) * inv); }
        }
        __syncthreads();
    }
    const float* sinks = p.in[8];
    for (int u = vcu; u < 2048; u += G) {
        const int blk = (u >> 2) & 31, kvh = (u >> 7) & 1, hq = kvh * 4 + (u & 3), b = u >> 8; const size_t rowb = (size_t)b * SEQ;
        const int t0 = blk * 256 + 32 * wave;
        const float slope = exp2f(-0.5f * (float)(hq + 1)), sink2 = sinks[hq] * LOG2E;
        f32x16 o[2]; float m, l;
        win_tile(QKV + 1536 + 64 * hq, QKV + 2048 + 64 * kvh, QKV + 2176 + 64 * kvh, rowb, t0, 1, 127, slope * LOG2E, sink2, hi == 0 ? 1.f : 0.f, vl, lane, o, m, l);
        l += __shfl_xor(l, 32);
        const float inv = 1.0f / l;
        bf16_t* yp = Y + (rowb + (size_t)(t0 + r32)) * DM + 512 + 64 * hq + 4 * hi;
#pragma unroll
        for (int dblk = 0; dblk < 2; ++dblk)
#pragma unroll
            for (int rg = 0; rg < 4; ++rg) store_o4(yp + 32 * dblk + 8 * rg, o[dblk][4 * rg] * inv, o[dblk][4 * rg + 1] * inv, o[dblk][4 * rg + 2] * inv, o[dblk][4 * rg + 3] * inv);
    }
}

constexpr int KPW = 144;
constexpr size_t WS_OP = 785 * MiB, WS_ML = 913 * MiB, WS_END2 = 921 * MiB;
__device__ __forceinline__ void blk_tile(const bf16x8 (&qf)[4], LAS const unsigned char* Kw, LAS const unsigned char* Vw, int rowoff, int t0w, int stride, int W, float slope2, float m_init, float l_init,
                                         int lane, f32x16 (&o)[2], float& m_out, float& l_out) {
    const int r32 = lane & 31, hi = lane >> 5;
    const unsigned vlane = (unsigned)((4 * hi + ((lane >> 2) & 3)) * VP + (16 * ((lane >> 4) & 1) + 4 * (lane & 3)) * 2);
    const float rowc = slope2 * (float)r32;
    float m = m_init + rowc, l = l_init;
#pragma unroll
    for (int r = 0; r < 16; ++r) { o[0][r] = 0.f; o[1][r] = 0.f; }
#pragma unroll 1
    for (int kt = 4; kt >= 0; --kt) {
        const int rel0 = (kt - 4) * 32;
        LAS const unsigned char* kb = Kw + (rowoff + 32 * kt + r32) * KPW + hi * 16;
        f32x16 p;
#pragma unroll
        for (int r = 0; r < 16; ++r) p[r] = 0.f;
#pragma unroll
        for (int d0 = 0; d0 < 4; ++d0) { const bf16x8 kf = *(LAS const bf16x8*)(kb + d0 * 32); p = MFMA32(kf, qf[d0], p); }
        const float cb = slope2 * (float)(rel0 + 4 * hi);
        float mx = -INFINITY;
        if (kt == 4 || kt == 0 || (t0w + rel0 * stride < 0)) {
#pragma unroll
            for (int r = 0; r < 16; ++r) { const int kv = (r & 3) + 8 * (r >> 2) + 4 * hi; const int dist = r32 - rel0 - kv; const int tkk = t0w + (rel0 + kv) * stride;
                const bool ok = (dist >= 0) && (dist <= W) && (tkk >= 0);
                p[r] = ok ? fmaf(slope2, (float)((r & 3) + 8 * (r >> 2)), p[r] + cb) : -INFINITY; mx = fmaxf(mx, p[r]); }
        } else {
#pragma unroll
            for (int r = 0; r < 16; ++r) { p[r] = fmaf(slope2, (float)((r & 3) + 8 * (r >> 2)), p[r] + cb); mx = fmaxf(mx, p[r]); }
        }
        mx = xmax32(mx);
        const float mn = fmaxf(m, mx);
        if (__any(mn > m)) {
            const float alpha = __builtin_amdgcn_exp2f(m - mn); l *= alpha;
#pragma unroll
            for (int r = 0; r < 16; ++r) { o[0][r] *= alpha; o[1][r] *= alpha; }
        }
        m = mn;
        float rs = 0.f;
#pragma unroll
        for (int r = 0; r < 16; ++r) { p[r] = __builtin_amdgcn_exp2f(p[r] - mn); rs += p[r]; }
        l += rs;
        const bf16x8 pb0 = pack8(p, 0), pb1 = pack8(p, 8);
        LAS const unsigned char* vb = Vw + (rowoff + 32 * kt) * VP + vlane;
#pragma unroll
        for (int dblk = 0; dblk < 2; ++dblk) {
            const bf16x8 a0 = vt_frag(vb + dblk * 64), a1 = vt_frag(vb + 16 * VP + dblk * 64);
            o[dblk] = MFMA32(a0, pb0, o[dblk]); o[dblk] = MFMA32(a1, pb1, o[dblk]);
        }
    }
    m_out = m - rowc; l_out = l;
}
struct WinUnit { int b, head, dil, tq0, nk, kcol, vcol, isB, kvh, br; };
__device__ __forceinline__ WinUnit win_decode(int u, int pass) {
    WinUnit w; w.isB = 0; w.kvh = 0; w.br = 0;
    if (pass == 1) { const int bhd = u >> 5, blk = u & 31; w.b = bhd >> 3; w.head = bhd & 7; w.dil = 1; w.tq0 = 256 * blk; w.nk = 6; w.kcol = 8 + w.head; w.vcol = 16 + w.head; }
    else if (u < 4096) { const int bhd = u >> 6, w6 = u & 63; w.b = bhd >> 3; w.head = bhd & 7;
        if (w6 < 32) { w.dil = 16; w.tq0 = (w6 >> 1) + 16 * 256 * (w6 & 1); w.br = 0; } else { const int x = w6 - 32; w.dil = 4; w.tq0 = (x >> 3) + 4 * 256 * (x & 7); w.br = 1; }
        w.nk = 6; w.kcol = 8 + w.head; w.vcol = 16 + w.head; }
    else { const int v = u - 4096, tb = v & 127; w.kvh = (v >> 7) & 1; w.b = v >> 8; w.head = 0; w.isB = 1; w.dil = 1; w.tq0 = 64 * tb; w.nk = 3; w.kcol = 32 + w.kvh; w.vcol = 34 + w.kvh; }
    return w;
}
struct WinWave { int rowoff, t0w, qcol, hq; };
__device__ __forceinline__ WinWave win_wave(const WinUnit& wu, int wave) {
    WinWave w; w.hq = 0;
    if (wu.isB) { const int g = wave >> 1, j = wave & 1; w.hq = 4 * wu.kvh + g; w.rowoff = 32 * j; w.t0w = wu.tq0 + 32 * j; w.qcol = 24 + w.hq; }
    else { w.rowoff = 32 * wave; w.t0w = wu.tq0 + 32 * wave * wu.dil; w.qcol = wu.head; }
    return w;
}
template <int PASS, int VAR = 0> __device__ __forceinline__ void phase_win2(const Params& p, LAS unsigned char* lds, int tid, int wave, int lane) {
    const bf16_t* QKV = (const bf16_t*)(p.ws + WS_R); bf16_t* Y = (bf16_t*)(p.ws + (VAR ? WS_XB : WS_Y));
    bf16_t* OP = (bf16_t*)(p.ws + WS_OP); float* ML = (float*)(p.ws + WS_ML);
    LAS unsigned char* Kw = lds; LAS unsigned char* Vw = lds + 384 * KPW;
    const int r32 = lane & 31, hi = lane >> 5, srow = tid >> 3, sc16 = tid & 7;
    const int G = gridDim.x, vcu = (G % 8 == 0) ? ((int)blockIdx.x % 8) * (G / 8) + (int)blockIdx.x / 8 : (int)blockIdx.x;
    constexpr int NU = PASS ? 2048 : 6144;
    const float* sinks = p.in[8];
    u32x4 kreg[6], vreg[6]; bf16x8 qn[4];
#define WIN_LOAD(WU) do { const size_t rb_ = (size_t)(WU).b * SEQ; \
        if (VAR != 2) _Pragma("unroll") for (int k = 0; k < 6; ++k) if (k < (WU).nk) { int tk_ = (WU).tq0 + (srow + 64 * k - 128) * (WU).dil; tk_ = tk_ < 0 ? 0 : tk_; \
            const size_t ro_ = (rb_ + (size_t)tk_) * 64 + 8 * sc16; kreg[k] = *(const u32x4*)(QKV + (size_t)(WU).kcol * MTOK * 64 + ro_); vreg[k] = *(const u32x4*)(QKV + (size_t)(WU).vcol * MTOK * 64 + ro_); } \
        const WinWave ww_ = win_wave((WU), wave); const bf16_t* qp_ = QKV + ((size_t)ww_.qcol * MTOK + rb_ + (size_t)(ww_.t0w + r32 * (WU).dil)) * 64 + 8 * hi; \
        _Pragma("unroll") for (int d0 = 0; d0 < 4; ++d0) qn[d0] = *(const bf16x8*)(qp_ + 16 * d0); } while (0)
    int u = vcu;
    if (u < NU) { const WinUnit w0 = win_decode(u, PASS); WIN_LOAD(w0); }
    for (; u < NU; u += G) {
        const WinUnit wu = win_decode(u, PASS);
        const WinWave ww = win_wave(wu, wave);
        const int rowoff = ww.rowoff, t0w = ww.t0w, hq = ww.hq;
        const size_t rowb = (size_t)wu.b * SEQ;
        const int qtok = t0w + r32 * wu.dil;
        const size_t tokrow = rowb + (size_t)qtok;
        bf16x8 qf[4];
#pragma unroll
        for (int d0 = 0; d0 < 4; ++d0) qf[d0] = qn[d0];
#pragma unroll
        for (int k = 0; k < 6; ++k) if (VAR != 2 && k < wu.nk) { *(LAS u32x4*)(Kw + (srow + 64 * k) * KPW + sc16 * 16) = kreg[k]; *(LAS u32x4*)(Vw + (srow + 64 * k) * VP + sc16 * 16) = vreg[k]; }
        asm volatile("s_waitcnt lgkmcnt(0)\n\ts_barrier" ::: "memory");
        if (u + G < NU) { const WinUnit wn = win_decode(u + G, PASS); WIN_LOAD(wn); }
        f32x16 o[2]; float m, l;
        if (PASS == 0 && wu.isB) {
            const float slope = exp2f(-0.5f * (float)(hq + 1)), sink2 = sinks[hq] * LOG2E;
            blk_tile(qf, Kw, Vw, rowoff, t0w, 1, 127, slope * LOG2E, sink2, hi == 0 ? 1.f : 0.f, lane, o, m, l);
            l += __shfl_xor(l, 32);
            const float inv = 1.0f / l;
            bf16_t* yp = Y + tokrow * DM + 512 + 64 * hq + 4 * hi;
#pragma unroll
            for (int dblk = 0; dblk < 2; ++dblk)
#pragma unroll
                for (int rg = 0; rg < 4; ++rg) store_o4(yp + 32 * dblk + 8 * rg, o[dblk][4 * rg] * inv, o[dblk][4 * rg + 1] * inv, o[dblk][4 * rg + 2] * inv, o[dblk][4 * rg + 3] * inv);
        } else if (PASS == 0) {
            const float slope = exp2f(-0.5f * (float)(9 + wu.head));
            blk_tile(qf, Kw, Vw, rowoff, t0w, wu.dil, 128, slope * (float)wu.dil * LOG2E, -INFINITY, 0.f, lane, o, m, l);
            l += __shfl_xor(l, 32);
            const float inv = 1.0f / l;
            bf16_t* op = OP + ((size_t)wu.br * MTOK + tokrow) * 512 + 64 * wu.head + 4 * hi;
#pragma unroll
            for (int dblk = 0; dblk < 2; ++dblk)
#pragma unroll
                for (int rg = 0; rg < 4; ++rg) store_o4(op + 32 * dblk + 8 * rg, o[dblk][4 * rg] * inv, o[dblk][4 * rg + 1] * inv, o[dblk][4 * rg + 2] * inv, o[dblk][4 * rg + 3] * inv);
            if (hi == 0) { float* ml = ML + (((size_t)wu.br * MTOK + tokrow) * 8 + wu.head) * 2; ml[0] = m; ml[1] = l; }
        } else {
            const float* ml16 = ML + (tokrow * 8 + wu.head) * 2; const float* ml4 = ML + (((size_t)MTOK + tokrow) * 8 + wu.head) * 2;
            const float m16 = ml16[0], l16 = ml16[1], m4 = ml4[0], l4 = ml4[1];
            const bf16_t* o16 = OP + tokrow * 512 + 64 * wu.head + 4 * hi; const bf16_t* o4 = OP + ((size_t)MTOK + tokrow) * 512 + 64 * wu.head + 4 * hi;
            u32x2 pa[2][4], pc[2][4];
#pragma unroll
            for (int dblk = 0; dblk < 2; ++dblk)
#pragma unroll
                for (int rg = 0; rg < 4; ++rg) { pa[dblk][rg] = *(const u32x2*)(o16 + 32 * dblk + 8 * rg); pc[dblk][rg] = *(const u32x2*)(o4 + 32 * dblk + 8 * rg); }
            const float slope = exp2f(-0.5f * (float)(9 + wu.head));
            if (VAR != 1) blk_tile(qf, Kw, Vw, rowoff, t0w, 1, 128, slope * LOG2E, -INFINITY, 0.f, lane, o, m, l);
            else { m = 0.f; l = 1.f; _Pragma("unroll") for (int r = 0; r < 16; ++r) { o[0][r] = __builtin_bit_cast(float, qf[0][r & 7] << 16); o[1][r] = o[0][r]; } }
            l += __shfl_xor(l, 32);
            const float M = fmaxf(m, fmaxf(m16, m4));
            float w1 = __builtin_amdgcn_exp2f(m - M), w16 = __builtin_amdgcn_exp2f(m16 - M) * l16, w4 = __builtin_amdgcn_exp2f(m4 - M) * l4;
            const float inv = 1.0f / (l * w1 + w16 + w4); w1 *= inv; w16 *= inv; w4 *= inv;
            bf16_t* yp = Y + tokrow * DM + 64 * wu.head + 4 * hi;
#pragma unroll
            for (int dblk = 0; dblk < 2; ++dblk)
#pragma unroll
                for (int rg = 0; rg < 4; ++rg) { const u32x2 a = pa[dblk][rg], c = pc[dblk][rg];
                    store_o4(yp + 32 * dblk + 8 * rg, o[dblk][4 * rg] * w1 + bf2f(a.x & 0xffffu) * w16 + bf2f(c.x & 0xffffu) * w4, o[dblk][4 * rg + 1] * w1 + bf2f(a.x >> 16) * w16 + bf2f(c.x >> 16) * w4,
                             o[dblk][4 * rg + 2] * w1 + bf2f(a.y & 0xffffu) * w16 + bf2f(c.y & 0xffffu) * w4, o[dblk][4 * rg + 3] * w1 + bf2f(a.y >> 16) * w16 + bf2f(c.y >> 16) * w4); }
        }
        asm volatile("s_waitcnt lgkmcnt(0)\n\ts_barrier" ::: "memory");
    }
#undef WIN_LOAD
}

__device__ __forceinline__ void phase_cumsum(const Params& p, LAS unsigned char* lds, int tid, int wave, int lane) {
    const float* logf = (const float*)(p.ws + WS_LOGF); bf16_t* KA = (bf16_t*)(p.ws + WS_KAUG); float* VF = (float*)(p.ws + WS_SCR);
    LAS double* wsum = (LAS double*)lds;
    for (int bh = blockIdx.x; bh < BATCH * 16; bh += gridDim.x) {
        const int b = bh >> 4, h = bh & 15, s0 = tid * 16;
        float v[16]; double tot = 0.0;
#pragma unroll
        for (int i = 0; i < 16; ++i) { v[i] = logf[((size_t)b * SEQ + s0 + i) * 16 + h]; tot += (double)v[i]; }
        double inc = tot;
#pragma unroll
        for (int o = 1; o < 64; o <<= 1) { const double n = __shfl_up(inc, o); if (lane >= o) inc += n; }
        if (lane == 63) wsum[wave] = inc;
        __syncthreads();
        double base = 0.0;
        for (int w = 0; w < wave; ++w) base += wsum[w];
        __syncthreads();
        double c = base + inc - tot;
#pragma unroll
        for (int i = 0; i < 16; ++i) { c += (double)v[i]; const float val = (float)(-c * 1.4426950408889634);
            const unsigned b0 = f2bf(val); const float r1 = val - bf2f(b0); const unsigned b1 = f2bf(r1); const float r2 = r1 - bf2f(b1); const unsigned b2 = f2bf(r2);
            u32x4 w; w.x = b0 | (b1 << 16); w.y = b2 | (0x3F80u << 16); w.z = 0x3F803F80u; w.w = 0u;
            *(u32x4*)(KA + ((size_t)bh * SEQ + s0 + i) * 8) = w; VF[(size_t)bh * SEQ + s0 + i] = val; }
    }
}

__device__ __forceinline__ void phase_fox(const Params& p, LAS unsigned char* lds, int tid, int wave, int lane, int qidx) {
    const bf16_t* QKV = (const bf16_t*)(p.ws + WS_R); const bf16_t* KA = (const bf16_t*)(p.ws + WS_KAUG); bf16_t* Y = (bf16_t*)(p.ws + WS_Y);
    constexpr int KP = 144, KB_BYTES = 64 * KP, VB_BYTES = 64 * VP;
    constexpr float THR = 16.f;
    LAS unsigned char* Kl = lds; LAS unsigned char* Vl = lds + 2 * KB_BYTES;
    const int r32 = lane & 31, hi = lane >> 5, srow = tid >> 3, sc16 = tid & 7;
    const unsigned vlane = (unsigned)((4 * hi + ((lane >> 2) & 3)) * VP + (16 * ((lane >> 4) & 1) + 4 * (lane & 3)) * 2);
    const float* VF = (const float*)(p.ws + WS_SCR);
    float gqm = 0.f, gkm = 0.f;
    for (int i = 0; i < 64; ++i) { gqm = fmaxf(gqm, fabsf(p.in[12][i])); gkm = fmaxf(gkm, fabsf(p.in[13][i])); }
    const float TH = __uint_as_float(__builtin_amdgcn_readfirstlane(__float_as_uint(2.1f * (64.0f * QSCALE * gqm * gkm) + 150.0f + THR)));
    unsigned* qctr = (unsigned*)(p.ws + WS_CTL) + 64 * qidx;
    LAS int* qslot = (LAS int*)(lds + 2 * KB_BYTES + 2 * VB_BYTES);
    const f32x16 zero16 = {0.f, 0.f, 0.f, 0.f, 0.f, 0.f, 0.f, 0.f, 0.f, 0.f, 0.f, 0.f, 0.f, 0.f, 0.f, 0.f};
#define SB_() __builtin_amdgcn_sched_barrier(0)
#define QKG0(N0, N1) do { const bf16x8 a0_ = *(LAS const bf16x8*)(kb_ + hi * 16), a1_ = *(LAS const bf16x8*)(kb_ + 32 * KP + hi * 16); N0 = MFMA32(a0_, qf[0], zero16); N1 = MFMA32(a1_, qf[0], zero16); } while (0)
#define QKG(D0, N0, N1) do { const bf16x8 a0_ = *(LAS const bf16x8*)(kb_ + hi * 16 + (D0) * 32), a1_ = *(LAS const bf16x8*)(kb_ + 32 * KP + hi * 16 + (D0) * 32); N0 = MFMA32(a0_, qf[D0], N0); N1 = MFMA32(a1_, qf[D0], N1); } while (0)
#define QKA(N0, N1) do { const bf16x8 a0_ = *(LAS const bf16x8*)(kb_ + 128), a1_ = *(LAS const bf16x8*)(kb_ + 32 * KP + 128); N0 = MFMA32(a0_, qaug, N0); N1 = MFMA32(a1_, qaug, N1); } while (0)
#define EXPR(C, LO, HI) do { _Pragma("unroll") for (int r = (LO); r < (HI); ++r) { C[r] = __builtin_amdgcn_exp2f(C[r]); rs_ += C[r]; } } while (0)
#define MAXR(N0, N1, LO, HI) do { _Pragma("unroll") for (int r = (LO); r < (HI); ++r) mx_ = max3f(mx_, N0[r], N1[r]); } while (0)
#define PVG(CC, SRC, BASE) do { const bf16x8 va_ = vt_frag(vb_ + (CC) * 16 * VP), vbb_ = vt_frag(vb_ + (CC) * 16 * VP + 64); const bf16x8 pa_ = pack8(SRC, BASE); o0 = MFMA32(va_, pa_, o0); o1 = MFMA32(vbb_, pa_, o1); } while (0)
#define FOX_MASK(S0, S1, T) do { if ((T) >= NT - 4 && 64 * (T) + 63 > q0 + 32 * wave) { const int kvb_ = 64 * (T) + 4 * hi; \
            _Pragma("unroll") for (int r = 0; r < 16; ++r) { const int kv = kvb_ + (r & 3) + 8 * (r >> 2); if (kv > qtok) S0[r] = -INFINITY; if (kv + 32 > qtok) S1[r] = -INFINITY; } } } while (0)
#define FOX_REREF(S0, S1, MX) do { if (__any((MX) > THR)) { const float dl_ = fmaxf((MX), 0.f); ref += dl_; \
            _Pragma("unroll") for (int r = 0; r < 16; ++r) { S0[r] -= dl_; S1[r] -= dl_; } \
            const float f_ = __builtin_amdgcn_exp2f(-dl_); l *= f_; \
            _Pragma("unroll") for (int r = 0; r < 16; ++r) { o0[r] *= f_; o1[r] *= f_; } \
            const float nv_ = -ref; const unsigned b0_ = f2bf(nv_); const float r1_ = nv_ - bf2f(b0_); const unsigned b1_ = f2bf(r1_); const float r2_ = r1_ - bf2f(b1_); const unsigned b2_ = f2bf(r2_); \
            if (hi == 0) { qaug[3] = (short)b0_; qaug[4] = (short)b1_; qaug[5] = (short)b2_; } } } while (0)
#define FOX_DECIDE(S0, S1, T) do { FOX_MASK(S0, S1, T); float mx_ = fmaxf(S0[0], S1[0]); MAXR(S0, S1, 1, 16); mx_ = xmax32(mx_); FOX_REREF(S0, S1, mx_); } while (0)
#define FOX_STAGE(T) do { const int t_ = (T); \
        if (t_ + 1 < NT) { *(LAS u32x4*)(Vl + ((t_ + 1) & 1) * VB_BYTES + srow * VP + sc16 * 16) = vr; \
            if (t_ + 2 < NT) { *(LAS u32x4*)(Kl + (t_ & 1) * KB_BYTES + srow * KP + sc16 * 16) = kr; if (tid < 64) *(LAS u32x4*)(Kl + (t_ & 1) * KB_BYTES + tid * KP + 128) = ar; } } \
        if (t_ + 2 < NT) { vr = *(const u32x4*)(vg + (size_t)(t_ + 2) * 64 * 64); \
            if (t_ + 3 < NT) { kr = *(const u32x4*)(kg + (size_t)(t_ + 3) * 64 * 64); if (tid < 64) ar = *(const u32x4*)(ag + (size_t)(t_ + 3) * 64 * 8); } } \
        asm volatile("s_waitcnt lgkmcnt(0)\n\ts_barrier" ::: "memory"); } while (0)
#define FOX_STAGEU(T) do { const int t_ = (T); \
        *(LAS u32x4*)(Vl + ((t_ + 1) & 1) * VB_BYTES + srow * VP + sc16 * 16) = vr; \
        *(LAS u32x4*)(Kl + (t_ & 1) * KB_BYTES + srow * KP + sc16 * 16) = kr; if (tid < 64) *(LAS u32x4*)(Kl + (t_ & 1) * KB_BYTES + tid * KP + 128) = ar; \
        vr = *(const u32x4*)(vg + (size_t)(t_ + 2) * 64 * 64); kr = *(const u32x4*)(kg + (size_t)(t_ + 3) * 64 * 64); if (tid < 64) ar = *(const u32x4*)(ag + (size_t)(t_ + 3) * 64 * 8); \
        asm volatile("s_waitcnt lgkmcnt(0)\n\ts_barrier" ::: "memory"); } while (0)
#define KLD(X0, X1, D0) do { X0 = *(LAS const bf16x8*)(kb_ + hi * 16 + (D0) * 32); X1 = *(LAS const bf16x8*)(kb_ + 32 * KP + hi * 16 + (D0) * 32); } while (0)
#define KLDA(X0, X1) do { X0 = *(LAS const bf16x8*)(kb_ + 128); X1 = *(LAS const bf16x8*)(kb_ + 32 * KP + 128); } while (0)
#define VLD(X0, X1, CC) do { X0 = vt_frag(vb_ + (CC) * 16 * VP); X1 = vt_frag(vb_ + (CC) * 16 * VP + 64); } while (0)
#define PVM(X0, X1, SRC, BASE) do { const bf16x8 pa_ = pack8(SRC, BASE); o0 = MFMA32(X0, pa_, o0); o1 = MFMA32(X1, pa_, o1); } while (0)
#define FOX_IT(C0, C1, N0, N1, T) do { const int ti_ = (T); float rs_ = 0.f; bf16x8 fa0_, fa1_, fb0_, fb1_; \
        LAS const unsigned char* kb_ = Kl + ((ti_ + 1) & 1) * KB_BYTES + r32 * KP; LAS const unsigned char* vb_ = Vl + (ti_ & 1) * VB_BYTES + vlane; \
        SB_(); KLD(fa0_, fa1_, 0); EXPR(C0, 0, 4); SB_(); \
        KLD(fb0_, fb1_, 1); N0 = MFMA32(fa0_, qf[0], zero16); N1 = MFMA32(fa1_, qf[0], zero16); EXPR(C0, 4, 10);  SB_(); \
        KLD(fa0_, fa1_, 2); N0 = MFMA32(fb0_, qf[1], N0);     N1 = MFMA32(fb1_, qf[1], N1);     EXPR(C0, 10, 16); SB_(); \
        KLD(fb0_, fb1_, 3); N0 = MFMA32(fa0_, qf[2], N0);     N1 = MFMA32(fa1_, qf[2], N1);     EXPR(C1, 0, 6);   SB_(); \
        KLDA(fa0_, fa1_);   N0 = MFMA32(fb0_, qf[3], N0);     N1 = MFMA32(fb1_, qf[3], N1);     EXPR(C1, 6, 12);  SB_(); \
        VLD(fb0_, fb1_, 0); N0 = MFMA32(fa0_, qaug, N0);      N1 = MFMA32(fa1_, qaug, N1);      EXPR(C1, 12, 16); SB_(); \
        l += rs_; \
        VLD(fa0_, fa1_, 1); PVM(fb0_, fb1_, C0, 0); SB_(); \
        float mx_ = fmaxf(N0[0], N1[0]); \
        VLD(fb0_, fb1_, 2); PVM(fa0_, fa1_, C0, 8); MAXR(N0, N1, 1, 6);  SB_(); \
        VLD(fa0_, fa1_, 3); PVM(fb0_, fb1_, C1, 0); MAXR(N0, N1, 6, 11); SB_(); \
        PVM(fa0_, fa1_, C1, 8); MAXR(N0, N1, 11, 16); SB_(); \
        mx_ = xmax32(mx_); FOX_REREF(N0, N1, mx_); \
        FOX_STAGEU(ti_); } while (0)
    for (;;) {
        if (tid == 0) *qslot = (int)atomicAdd(qctr, 1u);
        __syncthreads();
        const int unit = *qslot;
        if (unit >= 4096) break;
        const int bh = 16 * (unit >> 9) + (unit & 15), b = bh >> 4, h = bh & 15; const size_t rowb = (size_t)b * SEQ;
        const int qb = 31 - ((unit & 511) >> 4), q0 = qb * 256, NT = 4 * (qb + 1);
        const int qtok = q0 + 32 * wave + r32, wmax = q0 + 32 * wave + 31;
        int T0;
        { const float vq0 = VF[(size_t)bh * SEQ + q0]; int pred = 0; if (tid < NT - 4) pred = (vq0 - VF[(size_t)bh * SEQ + 64 * tid + 63] > TH) ? 1 : 0; T0 = __syncthreads_count(pred); }
        bf16x8 qf[4];
        { const bf16_t* qp = QKV + ((size_t)h * MTOK + rowb + (size_t)qtok) * 64 + 8 * hi;
#pragma unroll
          for (int d0 = 0; d0 < 4; ++d0) qf[d0] = *(const bf16x8*)(qp + 16 * d0); }
        bf16x8 qaug;
#pragma unroll
        for (int i = 0; i < 8; ++i) qaug[i] = (short)((hi == 0 && i < 3) ? 0x3F80 : 0);
        const bf16_t* kg = QKV + ((size_t)(16 + h) * MTOK + rowb + (size_t)srow) * 64 + 8 * sc16;
        const bf16_t* vg = QKV + ((size_t)(32 + h) * MTOK + rowb + (size_t)srow) * 64 + 8 * sc16;
        const bf16_t* ag = KA + ((size_t)bh * SEQ + (size_t)(tid & 63)) * 8;
        u32x4 kr, vr, ar = (u32x4){0u, 0u, 0u, 0u};
        {
            const u32x4 k0 = *(const u32x4*)(kg + (size_t)T0 * 64 * 64), k1 = *(const u32x4*)(kg + (size_t)(T0 + 1) * 64 * 64), v0 = *(const u32x4*)(vg + (size_t)T0 * 64 * 64);
            u32x4 a0 = ar, a1 = ar; if (tid < 64) { a0 = *(const u32x4*)(ag + (size_t)T0 * 64 * 8); a1 = *(const u32x4*)(ag + (size_t)(T0 + 1) * 64 * 8); }
            kr = *(const u32x4*)(kg + (size_t)(T0 + 2) * 64 * 64); vr = *(const u32x4*)(vg + (size_t)(T0 + 1) * 64 * 64); if (tid < 64) ar = *(const u32x4*)(ag + (size_t)(T0 + 2) * 64 * 8);
            const int s0 = T0 & 1, s1 = s0 ^ 1;
            *(LAS u32x4*)(Kl + s0 * KB_BYTES + srow * KP + sc16 * 16) = k0; *(LAS u32x4*)(Kl + s1 * KB_BYTES + srow * KP + sc16 * 16) = k1; *(LAS u32x4*)(Vl + s0 * VB_BYTES + srow * VP + sc16 * 16) = v0;
            if (tid < 64) { *(LAS u32x4*)(Kl + s0 * KB_BYTES + tid * KP + 128) = a0; *(LAS u32x4*)(Kl + s1 * KB_BYTES + tid * KP + 128) = a1; }
        }
        __syncthreads();
        float ref = 0.f, l = 0.f; f32x16 o0 = zero16, o1 = zero16;
        f32x16 sA0, sA1, sB0 = zero16, sB1 = zero16;
        { LAS const unsigned char* kb_ = Kl + (T0 & 1) * KB_BYTES + r32 * KP; QKG0(sA0, sA1); QKG(1, sA0, sA1); QKG(2, sA0, sA1); QKG(3, sA0, sA1); QKA(sA0, sA1); }
        asm volatile("s_waitcnt lgkmcnt(0)\n\ts_barrier" ::: "memory");
        FOX_DECIDE(sA0, sA1, T0);
        int t = T0;
        for (; t + 1 <= NT - 6; t += 2) { FOX_IT(sA0, sA1, sB0, sB1, t); FOX_IT(sB0, sB1, sA0, sA1, t + 1); }
        if (t <= NT - 6) { FOX_IT(sA0, sA1, sB0, sB1, t); sA0 = sB0; sA1 = sB1; ++t; }
        for (; t < NT; ++t) {
            const bool v0_ = 64 * t <= wmax, v1_ = (t + 1 < NT) && (64 * (t + 1) <= wmax);
            if (v1_) { LAS const unsigned char* kb_ = Kl + ((t + 1) & 1) * KB_BYTES + r32 * KP; QKG0(sB0, sB1); QKG(1, sB0, sB1); QKG(2, sB0, sB1); QKG(3, sB0, sB1); QKA(sB0, sB1); }
            SB_();
            if (v0_) { float rs_ = 0.f; EXPR(sA0, 0, 16); EXPR(sA1, 0, 16); l += rs_;
                LAS const unsigned char* vb_ = Vl + (t & 1) * VB_BYTES + vlane; PVG(0, sA0, 0); PVG(1, sA0, 8); PVG(2, sA1, 0); PVG(3, sA1, 8); }
            SB_();
            if (v1_) { FOX_DECIDE(sB0, sB1, t + 1); sA0 = sB0; sA1 = sB1; }
            FOX_STAGE(t);
        }
        l = xadd32(l);
        const float inv = 1.0f / l;
        bf16_t* yp = Y + (rowb + (size_t)qtok) * DM + 64 * h + 4 * hi;
#pragma unroll
        for (int rg = 0; rg < 4; ++rg) { store_o4(yp + 8 * rg, o0[4 * rg] * inv, o0[4 * rg + 1] * inv, o0[4 * rg + 2] * inv, o0[4 * rg + 3] * inv);
            store_o4(yp + 32 + 8 * rg, o1[4 * rg] * inv, o1[4 * rg + 1] * inv, o1[4 * rg + 2] * inv, o1[4 * rg + 3] * inv); }
    }
#undef SB_
#undef QKG0
#undef QKG
#undef QKA
#undef EXPR
#undef MAXR
#undef PVG
#undef FOX_MASK
#undef FOX_REREF
#undef FOX_DECIDE
#undef FOX_STAGE
#undef FOX_STAGEU
#undef FOX_IT
#undef KLD
#undef KLDA
#undef VLD
#undef PVM
}

typedef unsigned gu32_plain;
#define XB_TMO      128
#define XB_XCNT(j)  (256  + 64 * (j))
#define XB_XSUB(j)  (1280 + 64 * (j))
#define XB_XGEN(j)  (2304 + 64 * (j))
#define XB_TOP      3328
#define XB_TOPGEN   3392
#define XCD_BAR_WORDS 3456
#define XB_SPIN_CAP (1u << 18)

__device__ __forceinline__ unsigned xb_ld(unsigned* p)              { return __hip_atomic_load(p, __ATOMIC_RELAXED, __HIP_MEMORY_SCOPE_AGENT); }
__device__ __forceinline__ unsigned xb_add(unsigned* p, unsigned v) { return __hip_atomic_fetch_add(p, v, __ATOMIC_RELAXED, __HIP_MEMORY_SCOPE_AGENT); }
__device__ __forceinline__ unsigned xb_xcc_id() { return (unsigned)__builtin_amdgcn_s_getreg((3 << 11) | 20) & 0xFu; }
#define XB_SPIN(cond, bar) do { unsigned _sp = 0; while (cond) { __builtin_amdgcn_s_sleep(1); \
    if ((++_sp & 255u) == 0u) { if (xb_ld(&(bar)[XB_TMO])) break; if (_sp > XB_SPIN_CAP) { atomicAdd(&(bar)[XB_TMO], 1u); break; } } } } while (0)

struct XcdBarrier {
    unsigned* bar; unsigned x;
    volatile LAS unsigned* st;
};

__device__ __forceinline__ XcdBarrier xcd_barrier_post(unsigned* bar, volatile LAS unsigned* st) {
    XcdBarrier b; b.bar = bar; b.x = xb_xcc_id(); b.st = st;
    if (threadIdx.x == 0) (void)xb_add(&bar[XB_XCNT(b.x)], 1u);
    return b;
}
__device__ __forceinline__ void xcd_barrier_complete(unsigned* bar, unsigned x, unsigned& nloc, unsigned& nx) {
    const unsigned G = gridDim.x * gridDim.y * gridDim.z;
    unsigned sum, cnt, mine, sp = 0u;
    for (;;) {
        sum = 0u; cnt = 0u; mine = 0u;
#pragma unroll
        for (unsigned j = 0; j < 16; ++j) { const unsigned c = xb_ld(&bar[XB_XCNT(j)]); sum += c; cnt += (c > 0u) ? 1u : 0u; mine = (j == x) ? c : mine; }
        if (sum == G) break;
        __builtin_amdgcn_s_sleep(1);
        if ((++sp & 255u) == 0u) { if (xb_ld(&bar[XB_TMO])) break; if (sp > XB_SPIN_CAP) { atomicAdd(&bar[XB_TMO], 1u); break; } }
    }
    nloc = mine > 0u ? mine : 1u; nx = cnt > 0u ? cnt : 1u;
}

__device__ __forceinline__ void xcd_barrier(const XcdBarrier& b) {
    asm volatile("s_waitcnt vmcnt(0)" ::: "memory");
    __syncthreads();
    if (threadIdx.x == 0) {
        unsigned* bar = b.bar;
        __builtin_amdgcn_s_waitcnt(0);
        unsigned nloc = b.st[0], nx = b.st[1];
        if (nloc == 0u) { xcd_barrier_complete(bar, b.x, nloc, nx); b.st[0] = nloc; b.st[1] = nx; }
        const unsigned old = xb_add(&bar[XB_XSUB(b.x)], 1u);
        const unsigned gen = old / nloc;
        if (old + 1u == (gen + 1u) * nloc) {
            __builtin_amdgcn_fence(__ATOMIC_RELEASE, "agent");
            asm volatile("s_waitcnt vmcnt(0)" ::: "memory");
            const unsigned og = xb_add(&bar[XB_TOP], 1u);
            const unsigned tg = og / nx;
            if (og + 1u == (tg + 1u) * nx) xb_add(&bar[XB_TOPGEN], 1u);
            else XB_SPIN(xb_ld(&bar[XB_TOPGEN]) == tg, bar);
            __builtin_amdgcn_fence(__ATOMIC_ACQUIRE, "agent");
            xb_add(&bar[XB_XGEN(b.x)], 1u);
            asm volatile("s_waitcnt vmcnt(0)" ::: "memory");
        } else {
            XB_SPIN(xb_ld(&bar[XB_XGEN(b.x)]) == gen, bar);
            __builtin_amdgcn_fence(__ATOMIC_ACQUIRE, "agent");
            asm volatile("s_waitcnt vmcnt(0)" ::: "memory");
        }
    }
    __syncthreads();
}

template <class Epi> __device__ __forceinline__ void run_gemm(LAS unsigned char* lds, const bf16_t* A, const bf16_t* Bt, int N, int K, const Epi& E) {
    pg8::Gemm g{A, Bt, MTOK, N, K}; pg8::StaticOrder S; S.init(MTOK, N, (int)gridDim.x, (int)blockIdx.x);
    pg8::gemm_phase<Epi, pg8::StaticOrder, true, true>(lds, g, S, E);
}

__global__ void __launch_bounds__(512, 2) mega_fwd(Params p) {
    extern __shared__ __attribute__((aligned(16))) unsigned char lds_raw[];
    LAS unsigned char* lds = (LAS unsigned char*)lds_raw;
    cg::grid_group grid = cg::this_grid();
    const int tid = threadIdx.x, lane = tid & 63, wave = __builtin_amdgcn_readfirstlane(tid >> 6);
    unsigned char* ws = p.ws;
    bf16_t* XB = (bf16_t*)(ws + WS_XB); bf16_t* R = (bf16_t*)(ws + WS_R); bf16_t* Y = (bf16_t*)(ws + WS_Y);
    float* ssq = (float*)(ws + WS_SSQ); float* logf = (float*)(ws + WS_LOGF);
    const int lo = p.lo, hi = p.hi;
    __shared__ unsigned xb_state[2];
    if (tid < 2) xb_state[tid] = 0u;
    __syncthreads();
    XcdBarrier xbar = xcd_barrier_post((unsigned*)(ws + WS_CTL + 4096), (volatile LAS unsigned*)xb_state);
#define IN(k) (lo <= (k) && (k) < hi)
#ifndef PROBE_SYNC2
#define PROBE_SYNC2 0
#endif
#define SEAM(k) do { if ((k) + 1 < hi) { if ((k) == 0) grid.sync(); else xcd_barrier(xbar); if (PROBE_SYNC2) { xcd_barrier(xbar); xcd_barrier(xbar); } } } while (0)
#ifndef PROBE_REP
#define PROBE_REP -1
#endif
#define PH(k, ...) if (IN(k)) { for (int rr_ = 0; rr_ < ((PROBE_REP == (k)) ? 2 : 1); ++rr_) { if (rr_) grid.sync(); __VA_ARGS__; } SEAM(k); }
    PH(0, phase_prologue(p, lds, wave, lane))
    PH(1, { EpiIn<0> E{R, ssq, p.in[4], p.in[5], p.in[6], p.in[7], nullptr, nullptr}; run_gemm(lds, XB, (const bf16_t*)(ws + WS_WINE), N_INE, DM, E); })
#ifndef PROBE_WIN1
#define PROBE_WIN1 0
#endif
    PH(2, { phase_win2<0>(p, lds, tid, wave, lane); xcd_barrier(xbar); phase_win2<1>(p, lds, tid, wave, lane); if (PROBE_WIN1) { grid.sync(); phase_win2<1, PROBE_WIN1>(p, lds, tid, wave, lane); grid.sync(); phase_win2<1, PROBE_WIN1>(p, lds, tid, wave, lane); } })
    PH(3, { EpiRes<true, false> E{p.in[0], p.out, XB, ssq}; run_gemm(lds, Y, (const bf16_t*)(ws + WS_WOUTE), DM, DM, E); })
    PH(4, { EpiUp E{R, ssq}; run_gemm(lds, XB, (const bf16_t*)(ws + WS_WUP), DFF, DM, E); })
    PH(5, { EpiRes<false, false> E{nullptr, p.out, XB, ssq}; run_gemm(lds, R, (const bf16_t*)(ws + WS_WDN), DM, DFF, E); })
    PH(6, { EpiIn<1> E{R, ssq, p.in[12], p.in[13], nullptr, nullptr, logf, p.in[11]}; run_gemm(lds, XB, (const bf16_t*)(ws + WS_WINO), N_INO_PAD, DM, E); })
    PH(7, phase_cumsum(p, lds, tid, wave, lane))
    PH(8, { if (wave >= 4) __builtin_amdgcn_s_setprio(1); phase_fox(p, lds, tid, wave, lane, rr_); __builtin_amdgcn_s_setprio(0); })
    PH(9, { EpiRes<false, false> E{nullptr, p.out, XB, ssq}; run_gemm(lds, Y, (const bf16_t*)(ws + WS_WOUTO), DM, DM, E); })
    PH(10, { EpiUp E{R, ssq}; run_gemm(lds, XB, (const bf16_t*)(ws + WS_WUP) + (size_t)DM * DFF, DFF, DM, E); })
    PH(11, { EpiRes<false, true> E{nullptr, p.out, XB, ssq}; run_gemm(lds, R, (const bf16_t*)(ws + WS_WDN) + (size_t)DM * DFF, DM, DFF, E); })
#undef PH
#undef IN
#undef SEAM
}

#ifndef MK_MULTI
#define MK_MULTI 0
#endif
extern "C" void kernel_launch(void* const* d_in, const int* in_sizes, int n_in, void* d_out, int out_size, void* d_ws, size_t ws_size, hipStream_t stream) {
    static int grid = 0;
    if (grid == 0) {
        if (n_in != 17 || out_size != MTOK * DM || ws_size < WS_END2) { fprintf(stderr, "kernel_launch: unexpected shapes (n_in %d out %d ws %zu)\n", n_in, out_size, ws_size); grid = -1; return; }
        int dev = 0, cus = 0, per_cu = 0;
        hipGetDevice(&dev); hipDeviceGetAttribute(&cus, hipDeviceAttributeMultiprocessorCount, dev);
        if (hipFuncSetAttribute((const void*)mega_fwd, hipFuncAttributeMaxDynamicSharedMemorySize, LDS_BYTES) != hipSuccess) { fprintf(stderr, "kernel_launch: hipFuncSetAttribute failed\n"); grid = -1; return; }
        if (hipOccupancyMaxActiveBlocksPerMultiprocessor(&per_cu, (const void*)mega_fwd, 512, LDS_BYTES) != hipSuccess || per_cu < 1) { fprintf(stderr, "kernel_launch: occupancy query gave %d\n", per_cu); per_cu = 1; }
        (void)hipGetLastError();
        grid = cus * per_cu; if (grid > 256) grid = 256;
    }
    if (grid < 0) return;
    Params p{};
    for (int i = 0; i < 17; ++i) p.in[i] = (const float*)d_in[i];
    p.out = (float*)d_out; p.ws = (unsigned char*)d_ws;
    if (hipMemsetAsync((unsigned char*)d_ws + WS_CTL, 0, 32768, stream) != hipSuccess) { fprintf(stderr, "kernel_launch: memset failed\n"); return; }
#if MK_MULTI
    for (int k = 0; k < 12; ++k) { p.lo = k; p.hi = k + 1; hipLaunchKernelGGL(mega_fwd, dim3(grid), dim3(512), LDS_BYTES, stream, p); }
#else
    p.lo = 0; p.hi = 12;
    void* args[] = {&p};
    hipError_t e = hipLaunchCooperativeKernel((const void*)mega_fwd, dim3(grid), dim3(512), args, LDS_BYTES, stream);
    if (e != hipSuccess) fprintf(stderr, "kernel_launch: cooperative launch failed: %s (grid %d)\n", hipGetErrorString(e), grid);
#endif
}
```
